# Optimizing an MI355X kernel written in HIP

```python
import jax
import jax.numpy as jnp
from jax import lax
import numpy as np

D_MODEL = 2048
BATCH = 4
SEQ = 2048
DEPTH = 1

HEAD_DIM = 128
NSA_HEADS = 8
NSA_KV_HEADS = 2
NSA_GROUP = NSA_HEADS // NSA_KV_HEADS
CMP_BLOCK = 32
CMP_STRIDE = 16
CMP_HIDDEN = 256
SEL_BLOCK = 64
SEL_TOP = 8
WINDOW = 512
MLA_HEADS = 8
MLA_Q_RANK = 384
MLA_KV_RANK = 256
MLA_NOPE_DIM = 128
MLA_ROPE_DIM = 64
MLA_V_DIM = 128
ROPE_THETA = 10000.0
D_FF = 5632
Q_BLOCK = 128
EPS = 1e-6
NEG = -1e30
FORCE_SCORE = 1e4

NSA_WIDTH = NSA_HEADS * HEAD_DIM
MLA_WIDTH = MLA_HEADS * MLA_V_DIM
MIX_WIDTH = NSA_WIDTH + MLA_WIDTH
NSA_KV_WIDTH = NSA_KV_HEADS * HEAD_DIM
MLA_QK_DIM = MLA_NOPE_DIM + MLA_ROPE_DIM
IN_SPLITS = (NSA_WIDTH,) + (NSA_KV_WIDTH,) * 6 + (NSA_HEADS * 3, MLA_Q_RANK, MLA_KV_RANK, MLA_ROPE_DIM)
IN_DIM = sum(IN_SPLITS)

kernel_name = "hybrid_nsa_mla_macaron_layer"


def rms_norm(x, g):
    xf = x.astype(jnp.float32)
    y = xf * lax.rsqrt(jnp.mean(xf * xf, axis=-1, keepdims=True) + EPS)
    return (y * g.astype(jnp.float32)).astype(x.dtype)


def swiglu(x, w_gate, w_up, w_down):
    return (jax.nn.silu(x @ w_gate) * (x @ w_up)) @ w_down


def masked_softmax(scores, mask):
    s = jnp.where(mask, scores.astype(jnp.float32), NEG)
    p = jax.nn.softmax(s, axis=-1)
    return jnp.where(mask, p, 0.0)


def alibi_slopes(n):
    return 2.0 ** (-8.0 * jnp.arange(1, n + 1, dtype=jnp.float32) / n)


def rope(x, pos):
    half = x.shape[-1] // 2
    inv = ROPE_THETA ** (-jnp.arange(half, dtype=jnp.float32) / half)
    ang = pos.astype(jnp.float32)[:, None] * inv[None, :]
    cos = jnp.cos(ang)[None, :, None, :]
    sin = jnp.sin(ang)[None, :, None, :]
    x1 = x[..., :half].astype(jnp.float32)
    x2 = x[..., half:].astype(jnp.float32)
    return jnp.concatenate([x1 * cos - x2 * sin, x2 * cos + x1 * sin], axis=-1).astype(x.dtype)


def compress_blocks(kv, cmp_idx, pos_emb, w1, w2):
    B = kv.shape[0]
    n_cmp = cmp_idx.shape[0]
    blocks = kv[:, cmp_idx] + pos_emb[None, None, :, None, :]
    flat = blocks.transpose(0, 1, 3, 2, 4).reshape(B, n_cmp, NSA_KV_HEADS, CMP_BLOCK * HEAD_DIM)
    return jax.nn.gelu(flat @ w1) @ w2


def nsa_mixer(q, k_cmp, v_cmp, k_sel, v_sel, k_win, v_win, gates, q_gain, k_gains,
              cmp_pos_k, cmp_w1_k, cmp_w2_k, cmp_pos_v, cmp_w1_v, cmp_w2_v):
    B, S = q.shape[0], q.shape[1]
    H, G, R, D = NSA_HEADS, NSA_KV_HEADS, NSA_GROUP, HEAD_DIM
    slopes = alibi_slopes(H).reshape(G, R)
    scale = D ** -0.5
    q = rms_norm(q.reshape(B, S, H, D), q_gain).reshape(B, S, G, R, D)
    gates = gates.reshape(B, S, G, R, 3)

    n_cmp = (S - CMP_BLOCK) // CMP_STRIDE + 1
    cmp_idx = np.arange(n_cmp)[:, None] * CMP_STRIDE + np.arange(CMP_BLOCK)[None, :]
    kc = rms_norm(compress_blocks(k_cmp.reshape(B, S, G, D), cmp_idx, cmp_pos_k, cmp_w1_k, cmp_w2_k), k_gains[0])
    vc = compress_blocks(v_cmp.reshape(B, S, G, D), cmp_idx, cmp_pos_v, cmp_w1_v, cmp_w2_v)
    cmp_end = jnp.asarray(cmp_idx[:, -1], jnp.int32)
    cmp_centre = jnp.asarray(cmp_idx[:, 0] + 0.5 * (CMP_BLOCK - 1), jnp.float32)

    n_sel = S // SEL_BLOCK
    top = min(SEL_TOP, n_sel)
    sel_start_np = np.arange(n_sel) * SEL_BLOCK
    overlap = jnp.asarray((cmp_idx[:, :1] < sel_start_np[None, :] + SEL_BLOCK)
                          & (cmp_idx[:, -1:] >= sel_start_np[None, :]), jnp.float32)
    sel_start = jnp.asarray(sel_start_np, jnp.int32)
    ks = rms_norm(k_sel.reshape(B, S, G, D), k_gains[1])
    ks_blocks = ks.reshape(B, n_sel, SEL_BLOCK, G, D).transpose(0, 3, 1, 2, 4)
    vs_blocks = v_sel.reshape(B, n_sel, SEL_BLOCK, G, D).transpose(0, 3, 1, 2, 4)
    bi = jnp.arange(B)[:, None, None, None]
    gi = jnp.arange(G)[None, :, None, None]

    kw = rms_norm(k_win.reshape(B, S, G, D), k_gains[2])
    kw_pad = jnp.pad(kw, ((0, 0), (WINDOW, 0), (0, 0), (0, 0)))
    vw_pad = jnp.pad(v_win.reshape(B, S, G, D), ((0, 0), (WINDOW, 0), (0, 0), (0, 0)))
    n_win = WINDOW + Q_BLOCK

    def block(qb):
        q0 = qb * Q_BLOCK
        t = q0 + jnp.arange(Q_BLOCK)
        qq = lax.dynamic_slice_in_dim(q, q0, Q_BLOCK, axis=1)
        gb = lax.dynamic_slice_in_dim(gates, q0, Q_BLOCK, axis=1)

        dist_c = t[:, None].astype(jnp.float32) - cmp_centre[None, :]
        s_c = jnp.einsum('bqgrd,bngd->bgrqn', qq, kc) * scale - slopes[:, :, None, None] * dist_c
        p_c = masked_softmax(s_c, cmp_end[None, :] <= t[:, None])
        o_c = jnp.einsum('bgrqn,bngd->bqgrd', p_c.astype(vc.dtype), vc)

        imp = jnp.einsum('bgrqn,ns->bgqs', p_c, overlap)
        blk = jnp.arange(n_sel)
        forced = (blk[None, :] == 0) | (blk[None, :] == t[:, None] // SEL_BLOCK)
        future = sel_start[None, :] > t[:, None]
        imp = jnp.where(future, NEG, jnp.where(forced, FORCE_SCORE, imp))
        _, idx = lax.top_k(imp, top)
        kg = ks_blocks[bi, gi, idx].reshape(B, G, Q_BLOCK, top * SEL_BLOCK, D)
        vg = vs_blocks[bi, gi, idx].reshape(B, G, Q_BLOCK, top * SEL_BLOCK, D)
        s_pos = (idx[..., None] * SEL_BLOCK + jnp.arange(SEL_BLOCK)).reshape(B, G, Q_BLOCK, top * SEL_BLOCK)
        dist_s = t[None, None, :, None] - s_pos
        s_s = (jnp.einsum('bqgrd,bgqkd->bgrqk', qq, kg) * scale
               - slopes[None, :, :, None, None] * dist_s[:, :, None].astype(jnp.float32))
        p_s = masked_softmax(s_s, (dist_s >= 0)[:, :, None])
        o_s = jnp.einsum('bgrqk,bgqkd->bqgrd', p_s.astype(vg.dtype), vg)

        kwb = lax.dynamic_slice_in_dim(kw_pad, q0, n_win, axis=1)
        vwb = lax.dynamic_slice_in_dim(vw_pad, q0, n_win, axis=1)
        w_pos = q0 - WINDOW + jnp.arange(n_win)
        dist_w = t[:, None] - w_pos[None, :]
        m_w = (w_pos[None, :] >= 0) & (dist_w >= 0) & (dist_w < WINDOW)
        s_w = (jnp.einsum('bqgrd,bkgd->bgrqk', qq, kwb) * scale
               - slopes[:, :, None, None] * dist_w.astype(jnp.float32))
        p_w = masked_softmax(s_w, m_w)
        o_w = jnp.einsum('bgrqk,bkgd->bqgrd', p_w.astype(vwb.dtype), vwb)

        return gb[..., 0:1] * o_c + gb[..., 1:2] * o_s + gb[..., 2:3] * o_w

    out = lax.map(block, jnp.arange(S // Q_BLOCK))
    return out.transpose(1, 0, 2, 3, 4, 5).reshape(B, S, NSA_WIDTH)


def mla_mixer(c_q, c_kv, k_rope, q_a_gain, w_uq, kv_a_gain, w_ukv, q_gain, k_gain):
    B, S = c_q.shape[0], c_q.shape[1]
    Hm = MLA_HEADS
    pos = jnp.arange(S)
    q = (rms_norm(c_q, q_a_gain) @ w_uq).reshape(B, S, Hm, MLA_QK_DIM)
    kv = (rms_norm(c_kv, kv_a_gain) @ w_ukv).reshape(B, S, Hm, MLA_NOPE_DIM + MLA_V_DIM)
    k_nope, v = kv[..., :MLA_NOPE_DIM], kv[..., MLA_NOPE_DIM:]
    k = jnp.concatenate([k_nope, jnp.broadcast_to(k_rope[:, :, None, :], (B, S, Hm, MLA_ROPE_DIM))], axis=-1)
    q = rms_norm(q, q_gain)
    k = rms_norm(k, k_gain)
    q = jnp.concatenate([q[..., :MLA_NOPE_DIM], rope(q[..., MLA_NOPE_DIM:], pos)], axis=-1)
    k = jnp.concatenate([k[..., :MLA_NOPE_DIM], rope(k[..., MLA_NOPE_DIM:], pos)], axis=-1)
    scale = MLA_QK_DIM ** -0.5

    def block(qb):
        q0 = qb * Q_BLOCK
        t = q0 + jnp.arange(Q_BLOCK)
        qq = lax.dynamic_slice_in_dim(q, q0, Q_BLOCK, axis=1)
        s = jnp.einsum('bqhd,bkhd->bhqk', qq, k) * scale
        p = masked_softmax(s, pos[None, :] <= t[:, None])
        return jnp.einsum('bhqk,bkhd->bqhd', p.astype(v.dtype), v)

    out = lax.map(block, jnp.arange(S // Q_BLOCK))
    return out.transpose(1, 0, 2, 3, 4).reshape(B, S, MLA_WIDTH)


def setup_inputs(seed: int = 0) -> dict:
    key = jax.random.key(seed)
    keys = iter(jax.random.split(key, 40))

    def dense(shape, fan_in):
        return jax.random.normal(next(keys), (DEPTH,) + shape, jnp.float32) * fan_in ** -0.5

    def gain(shape):
        return 1.0 + 0.02 * jax.random.normal(next(keys), (DEPTH,) + shape, jnp.float32)

    def small(shape):
        return 0.1 * jax.random.normal(next(keys), (DEPTH,) + shape, jnp.float32)

    x = jax.random.normal(next(keys), (BATCH, SEQ, D_MODEL), jnp.float32)
    return {
        "x": x,
        "ffn1_norm": gain((D_MODEL,)),
        "ffn1_w_gate": dense((D_MODEL, D_FF), D_MODEL),
        "ffn1_w_up": dense((D_MODEL, D_FF), D_MODEL),
        "ffn1_w_down": dense((D_FF, D_MODEL), D_FF),
        "mix_norm": gain((D_MODEL,)),
        "w_in": dense((D_MODEL, IN_DIM), D_MODEL),
        "nsa_q_norm": gain((HEAD_DIM,)),
        "nsa_k_norm": gain((3, HEAD_DIM)),
        "nsa_cmp_pos_k": small((CMP_BLOCK, HEAD_DIM)),
        "nsa_cmp_w1_k": dense((CMP_BLOCK * HEAD_DIM, CMP_HIDDEN), CMP_BLOCK * HEAD_DIM),
        "nsa_cmp_w2_k": dense((CMP_HIDDEN, HEAD_DIM), CMP_HIDDEN),
        "nsa_cmp_pos_v": small((CMP_BLOCK, HEAD_DIM)),
        "nsa_cmp_w1_v": dense((CMP_BLOCK * HEAD_DIM, CMP_HIDDEN), CMP_BLOCK * HEAD_DIM),
        "nsa_cmp_w2_v": dense((CMP_HIDDEN, HEAD_DIM), CMP_HIDDEN),
        "mla_q_a_norm": gain((MLA_Q_RANK,)),
        "mla_w_uq": dense((MLA_Q_RANK, MLA_HEADS * MLA_QK_DIM), MLA_Q_RANK),
        "mla_kv_a_norm": gain((MLA_KV_RANK,)),
        "mla_w_ukv": dense((MLA_KV_RANK, MLA_HEADS * (MLA_NOPE_DIM + MLA_V_DIM)), MLA_KV_RANK),
        "mla_q_norm": gain((MLA_QK_DIM,)),
        "mla_k_norm": gain((MLA_QK_DIM,)),
        "out_norm_nsa": gain((NSA_WIDTH,)),
        "out_norm_mla": gain((MLA_WIDTH,)),
        "w_out": dense((MIX_WIDTH, D_MODEL), MIX_WIDTH),
        "ffn2_norm": gain((D_MODEL,)),
        "ffn2_w_gate": dense((D_MODEL, D_FF), D_MODEL),
        "ffn2_w_up": dense((D_MODEL, D_FF), D_MODEL),
        "ffn2_w_down": dense((D_FF, D_MODEL), D_FF),
    }


def reference(x, ffn1_norm, ffn1_w_gate, ffn1_w_up, ffn1_w_down, mix_norm, w_in,
              nsa_q_norm, nsa_k_norm, nsa_cmp_pos_k, nsa_cmp_w1_k, nsa_cmp_w2_k,
              nsa_cmp_pos_v, nsa_cmp_w1_v, nsa_cmp_w2_v,
              mla_q_a_norm, mla_w_uq, mla_kv_a_norm, mla_w_ukv, mla_q_norm, mla_k_norm,
              out_norm_nsa, out_norm_mla, w_out,
              ffn2_norm, ffn2_w_gate, ffn2_w_up, ffn2_w_down):
    offsets = [int(v) for v in np.cumsum(IN_SPLITS)[:-1]]
    for l in range(DEPTH):
        h = rms_norm(x, ffn1_norm[l])
        x = x + 0.5 * swiglu(h, ffn1_w_gate[l], ffn1_w_up[l], ffn1_w_down[l])

        h = rms_norm(x, mix_norm[l])
        proj = h @ w_in[l]
        (q_a, k_cmp, v_cmp, k_sel, v_sel, k_win, v_win, g_a,
         c_q, c_kv, k_rope) = jnp.split(proj, offsets, axis=-1)
        gates = jax.nn.sigmoid(g_a.astype(jnp.float32)).astype(x.dtype)
        o_a = nsa_mixer(q_a, k_cmp, v_cmp, k_sel, v_sel, k_win, v_win, gates,
                        nsa_q_norm[l], nsa_k_norm[l],
                        nsa_cmp_pos_k[l], nsa_cmp_w1_k[l], nsa_cmp_w2_k[l],
                        nsa_cmp_pos_v[l], nsa_cmp_w1_v[l], nsa_cmp_w2_v[l])
        o_b = mla_mixer(c_q, c_kv, k_rope, mla_q_a_norm[l], mla_w_uq[l],
                        mla_kv_a_norm[l], mla_w_ukv[l], mla_q_norm[l], mla_k_norm[l])
        mixed = jnp.concatenate([rms_norm(o_a, out_norm_nsa[l]), rms_norm(o_b, out_norm_mla[l])], axis=-1)
        x = x + mixed @ w_out[l]

        h = rms_norm(x, ffn2_norm[l])
        x = x + 0.5 * swiglu(h, ffn2_w_gate[l], ffn2_w_up[l], ffn2_w_down[l])
    return x
```

```cpp
#include <hip/hip_runtime.h>
#include <hip/hip_cooperative_groups.h>
#include <cstdio>
#include <cstdint>
namespace cg = cooperative_groups;

#ifndef MK_ONE_LAUNCH
#define MK_ONE_LAUNCH 1
#endif
#ifndef MK_NO_CG
#define MK_NO_CG 2
#endif

#define DI __device__ __forceinline__
typedef unsigned short bf16_t;
typedef short bf16x8 __attribute__((ext_vector_type(8)));
typedef float f32x4 __attribute__((ext_vector_type(4)));
typedef float f32x2 __attribute__((ext_vector_type(2)));
typedef unsigned u32x4 __attribute__((ext_vector_type(4)));
typedef unsigned u32x2 __attribute__((ext_vector_type(2)));

constexpr int NB = 4, SEQ = 2048, DM = 2048, T = NB * SEQ, DFF = 5632;
constexpr int NPROJ = 3328;
constexpr int PC_Q = 0, PC_KCMP = 1024, PC_VCMP = 1280, PC_KSEL = 1536, PC_VSEL = 1792, PC_KWIN = 2048, PC_VWIN = 2304,
              PC_CQ = 2560, PC_KROPE = 2944, PC_GATE = 3008, PC_CKV = 3072;
constexpr float EPS = 1e-6f;
constexpr int NSPLIT = 16;
constexpr int NBIASP = 32;
constexpr int WGU2_DEF0 = 4200, WGU2_DEF1 = 5632, WGU2_GDEF = 1600, WGU2_GQ = 2800, WGU2_GC = 4800;

constexpr size_t MiB = 1u << 20;
constexpr size_t WS_CTL = 0;
constexpr size_t WS_SS = 0;
constexpr size_t WS_BAR = 768 * 1024;
constexpr size_t WS_SSO = 256 * 1024;
constexpr size_t WS_WGU1 = 1 * MiB;
constexpr size_t WS_CSLAB = WS_WGU1 + 22 * MiB;
constexpr size_t WS_WD1 = WS_WGU1 + 44 * MiB;
constexpr size_t WS_WGU2 = WS_WD1 + 22 * MiB;
constexpr size_t WS_WD2 = WS_WGU2 + 44 * MiB;
constexpr size_t WS_WIN = WS_WD2 + 22 * MiB;
constexpr size_t WS_WOUT = WS_WIN + 13 * MiB;
constexpr size_t WS_WUQ = WS_WOUT + 8 * MiB;
constexpr size_t WS_WUKV = WS_WUQ + 2 * MiB;
constexpr size_t WS_WC1K = WS_WUKV + 1 * MiB;
constexpr size_t WS_WC1V = WS_WC1K + 2 * MiB;
constexpr size_t WS_H = WS_WC1V + 2 * MiB;
constexpr size_t WS_R1 = WS_H + 32 * MiB;
constexpr size_t WS_ACT = WS_R1;
constexpr size_t WS_PROJ = WS_R1;
constexpr size_t WS_QM = WS_R1;
constexpr size_t WS_KNRAW = WS_QM + 24 * MiB;
constexpr size_t WS_KM = WS_KNRAW + 16 * MiB;
constexpr size_t WS_VM = WS_KM + 24 * MiB;
constexpr size_t WS_R2 = WS_R1 + 88 * MiB;
constexpr size_t WS_H2 = WS_R2;
constexpr size_t WS_QN = WS_R2;
constexpr size_t WS_KS = WS_QN + 16 * MiB;
constexpr size_t WS_VS = WS_KS + 4 * MiB;
constexpr size_t WS_KW = WS_VS + 4 * MiB;
constexpr size_t WS_VW = WS_KW + 4 * MiB;
constexpr size_t WS_KCMP = WS_VW + 4 * MiB;
constexpr size_t WS_VCMP = WS_KCMP + 5 * MiB;
constexpr size_t WS_CQ = WS_VCMP + 5 * MiB;
constexpr size_t WS_CKV = WS_CQ + 6 * MiB;
constexpr size_t WS_KROPE = WS_CKV + 4 * MiB;
constexpr size_t WS_GATES = WS_KROPE + 2 * MiB;
constexpr size_t WS_KC = WS_GATES + 1 * MiB;
constexpr size_t WS_VC = WS_KC + 512 * 1024;
constexpr size_t WS_BIASP = WS_VC + 512 * 1024;
constexpr size_t WS_SSQCQ = WS_BIASP + 128 * 1024;
constexpr size_t WS_SSQCKV = WS_BIASP + 576 * 1024;
constexpr size_t WS_SSQKR = WS_BIASP + 896 * 1024;
constexpr size_t WS_ROPE = WS_BIASP + 1 * MiB;
constexpr size_t WS_SLAB = WS_ROPE + 1 * MiB;
constexpr size_t WS_END = WS_SLAB + 32 * MiB;
static_assert(WS_END <= 380 * MiB, "workspace map too large");

constexpr int LDS_BYTES = 147456;
constexpr int NTHREADS = 512;

DI float bf2f(bf16_t v) { return __uint_as_float((unsigned)v << 16); }
DI unsigned f2bf(float f) { unsigned u = __float_as_uint(f); return (u + 0x7fffu + ((u >> 16) & 1u)) >> 16; }
DI unsigned pk2(float lo, float hi) { return f2bf(lo) | (f2bf(hi) << 16); }
DI float lo2f(unsigned w) { return __uint_as_float(w << 16); }
DI float hi2f(unsigned w) { return __uint_as_float(w & 0xffff0000u); }
DI float wave_sum(float v) {
#pragma unroll
    for (int o = 1; o < 64; o <<= 1) v += __shfl_xor(v, o);
    return v;
}
DI float wave_max(float v) {
#pragma unroll
    for (int o = 1; o < 64; o <<= 1) v = fmaxf(v, __shfl_xor(v, o));
    return v;
}

DI int opaque_int(int v) { asm volatile("" : "+s"(v)); return v; }
struct Args {
    const float* in[28];
    float* out;
    unsigned char* ws;
    int ph_lo, ph_hi;
};

struct MapId { int off; DI int operator()(int n) const { return n + off; } };
struct MapGU { int half; DI int operator()(int n) const { return (n >> 7) * 256 + half * 128 + (n & 127); } };
struct MapWin {
    DI int operator()(int n) const {
        if (n < 2560) return n;
        if (n < 2584) return PC_GATE + (n - 2560);
        if (n < 2968) return PC_CQ + (n - 2584);
        if (n < 3224) return PC_CKV + (n - 2968);
        return PC_KROPE + (n - 3224);
    }
};
DI unsigned pk4_fp8(float a, float b, float c, float d) {
    int w = 0;
    w = __builtin_amdgcn_cvt_pk_fp8_f32(__builtin_amdgcn_fmed3f(a, -448.f, 448.f), __builtin_amdgcn_fmed3f(b, -448.f, 448.f), w, false);
    w = __builtin_amdgcn_cvt_pk_fp8_f32(__builtin_amdgcn_fmed3f(c, -448.f, 448.f), __builtin_amdgcn_fmed3f(d, -448.f, 448.f), w, true);
    return (unsigned)w;
}
DI unsigned pk4_i8(float a, float b, float c, float d) {
    unsigned w = 0;
    w = __builtin_amdgcn_cvt_pk_u8_f32(__builtin_rintf(a) + 128.f, 0, w); w = __builtin_amdgcn_cvt_pk_u8_f32(__builtin_rintf(b) + 128.f, 1, w);
    w = __builtin_amdgcn_cvt_pk_u8_f32(__builtin_rintf(c) + 128.f, 2, w); w = __builtin_amdgcn_cvt_pk_u8_f32(__builtin_rintf(d) + 128.f, 3, w);
    return w ^ 0x80808080u;
}
constexpr int F8_WD_SCALE = 2048; constexpr float F8_ASCALE = 16.0f;
constexpr int I8_W_SCALE = 1437;
constexpr float I8_H1_SCALE = 31.75f, I8_X2_SCALE = 20.0f;
template <class Map, int F8S = 0, bool I8 = false>
DI void transpose_all(const float* W, int K, int N, bf16_t* WT, const Map& map, const float* gain, float* scr, int gw, int ngw, int lane, const float* gain2 = nullptr, int gsplit = 1 << 30, int it0 = 0, int it1 = 1 << 30) {
    const int nblk = (N + 31) / 32, nitems = min((K / 64) * nblk, it1);
    float v[32];
    int it = it0 + gw;
#define TR_LOAD(item) do { const int kb_ = (item) / nblk, nb_ = (item) % nblk; const int nl_ = 32 * nb_ + (lane & 31); const float* wp_ = W + (size_t)(64 * kb_ + (lane >> 5)) * N + nl_; \
        _Pragma("unroll") for (int i = 0; i < 32; ++i) v[i] = (nl_ < N) ? wp_[(size_t)(2 * i) * N] : 0.f; } while (0)
    if (it < nitems) TR_LOAD(it);
    for (; it < nitems; it += ngw) {
        const int kb = it / nblk, nb = it % nblk, k0 = 64 * kb, n0 = 32 * nb;
        if (gain) {
            const float* gp = (k0 < gsplit) ? gain + k0 : gain2 + (k0 - gsplit);
#pragma unroll
            for (int i = 0; i < 32; ++i) v[i] *= gp[2 * i + (lane >> 5)];
        }
#pragma unroll
        for (int i = 0; i < 32; ++i) scr[(2 * i + (lane >> 5)) * 33 + (lane & 31)] = v[i];
        const int itn = it + ngw;
        if (itn < nitems) TR_LOAD(itn);
        __builtin_amdgcn_s_waitcnt(0xc07f); asm volatile("" ::: "memory");
        const int c = lane & 7;
#pragma unroll
        for (int j = 0; j < 4; ++j) {
            const int n = (lane >> 3) + 8 * j; const float* sp = scr + (8 * c) * 33 + n;
            if constexpr (F8S != 0) { constexpr float F8_WSCALE = (float)F8S;
                u32x2 o;
                if constexpr (I8) { o.x = pk4_i8(sp[0 * 33] * F8_WSCALE, sp[1 * 33] * F8_WSCALE, sp[2 * 33] * F8_WSCALE, sp[3 * 33] * F8_WSCALE);
                    o.y = pk4_i8(sp[4 * 33] * F8_WSCALE, sp[5 * 33] * F8_WSCALE, sp[6 * 33] * F8_WSCALE, sp[7 * 33] * F8_WSCALE); }
                else { o.x = pk4_fp8(sp[0 * 33] * F8_WSCALE, sp[1 * 33] * F8_WSCALE, sp[2 * 33] * F8_WSCALE, sp[3 * 33] * F8_WSCALE);
                    o.y = pk4_fp8(sp[4 * 33] * F8_WSCALE, sp[5 * 33] * F8_WSCALE, sp[6 * 33] * F8_WSCALE, sp[7 * 33] * F8_WSCALE); }
                if (n0 + n < N) *(u32x2*)((unsigned char*)WT + (size_t)map(n0 + n) * K + k0 + 8 * c) = o;
            } else {
            u32x4 o; o.x = pk2(sp[0 * 33], sp[1 * 33]); o.y = pk2(sp[2 * 33], sp[3 * 33]); o.z = pk2(sp[4 * 33], sp[5 * 33]); o.w = pk2(sp[6 * 33], sp[7 * 33]);
            if (n0 + n < N) *(u32x4*)(WT + (size_t)map(n0 + n) * K + k0 + 8 * c) = o; }
        }
        __builtin_amdgcn_s_waitcnt(0xc07f); asm volatile("" ::: "memory");
    }
#undef TR_LOAD
}

DI void rmsnorm_row2048_i8(const float* xrow, const float* g, unsigned char* orow, int lane) {
    f32x4 v[8]; float ss = 0.f;
#pragma unroll
    for (int j = 0; j < 8; ++j) { v[j] = *(const f32x4*)(xrow + 256 * j + 4 * lane); ss += (v[j].x * v[j].x + v[j].y * v[j].y) + (v[j].z * v[j].z + v[j].w * v[j].w); }
    const float r = I8_H1_SCALE / sqrtf(wave_sum(ss) * (1.0f / 2048.0f) + EPS);
#pragma unroll
    for (int j = 0; j < 8; ++j) {
        const f32x4 gg = *(const f32x4*)(g + 256 * j + 4 * lane);
        *(unsigned*)(orow + 256 * j + 4 * lane) = pk4_i8(v[j].x * r * gg.x, v[j].y * r * gg.y, v[j].z * r * gg.z, v[j].w * r * gg.w);
    }
}
DI void rmsnorm_row2048(const float* xrow, const float* g, bf16_t* orow, int lane) {
    f32x4 v[8]; float ss = 0.f;
#pragma unroll
    for (int j = 0; j < 8; ++j) { v[j] = *(const f32x4*)(xrow + 256 * j + 4 * lane); ss += (v[j].x * v[j].x + v[j].y * v[j].y) + (v[j].z * v[j].z + v[j].w * v[j].w); }
    const float r = 1.0f / sqrtf(wave_sum(ss) * (1.0f / 2048.0f) + EPS);
#pragma unroll
    for (int j = 0; j < 8; ++j) {
        const f32x4 gg = *(const f32x4*)(g + 256 * j + 4 * lane);
        u32x2 o; o.x = pk2(v[j].x * r * gg.x, v[j].y * r * gg.y); o.y = pk2(v[j].z * r * gg.z, v[j].w * r * gg.w);
        *(u32x2*)(orow + 256 * j + 4 * lane) = o;
    }
}

#ifndef P6_MERGED
#define P6_MERGED 0
#endif
#ifndef PG8_SP2
#define PG8_SP2 1
#endif
namespace pg8 {
#define PG8_LAS __attribute__((address_space(3)))
constexpr int BM = 256, BK = 64, HALF = 128, HTB = HALF * BK * 2, STAGE_BYTES = 8 * HTB, NXCD = 8, WGM = 4;
DI int lds_byte(int r, int c) { const int st = (r >> 4) * 2 + (c >> 5), rr = r & 15, cc = c & 31, ob = rr * 64 + cc * 2; return st * 1024 + (ob ^ (((ob >> 9) & 1) << 5)); }
DI void stage_rc(int b, int& R, int& C) { const int st = b / 1024, sb = b % 1024, swz = sb ^ (((sb >> 9) & 1) << 5); R = (st >> 1) * 16 + swz / 64; C = (st & 1) * 32 + (swz % 64) / 2; }
DI int perm32(int rho) { const int n = rho >> 4, i = rho & 15; return 8 * (i >> 2) + 4 * n + (i & 3); }
struct Unit { const char* A; const char* B; int pm, pn, aux, type; };
DI int mg_lda(int t) { return t == 0 ? 768 : (t == 1 ? 512 : 4096); }
DI int mg_ldb(int t) { return t == 0 ? 768 : (t == 1 ? 512 : 8192); }
DI int mg_nt(int t) { return t == 0 ? 6 : 4; }
DI int mg_perm(int t) { return t == 2 ? 0 : 1; }
struct Gemm { long lda, ldb; int K; };

struct TileOrder {
    const bf16_t* A; const bf16_t* Bt; long lda, ldb; int nM, nN, nwg, G, c;
    DI void init(const bf16_t* A_, const bf16_t* Bt_, long lda_, long ldb_, int M, int N, int G_, int c_) { A = A_; Bt = Bt_; lda = lda_; ldb = ldb_; nM = M / BM; nN = N / BM; nwg = nM * nN; G = G_; c = c_; }
    DI bool next(int i, Unit& u) const {
        const int L = i * G + c; if (L >= nwg) return false;
        int wgid = L; { const int q = nwg / NXCD, r = nwg % NXCD, xcd = wgid % NXCD, off = wgid / NXCD; wgid = (xcd < r ? xcd * (q + 1) : r * (q + 1) + (xcd - r) * q) + off; }
        const int nig = WGM * nN, gid = wgid / nig, fm = gid * WGM, gsz = (nM - fm) < WGM ? (nM - fm) : WGM;
        u.pm = fm + ((wgid % nig) % gsz); u.pn = (wgid % nig) / gsz; u.aux = 0;
        u.A = (const char*)(A + (size_t)u.pm * BM * lda); u.B = (const char*)(Bt + (size_t)u.pn * BM * ldb); return true;
    }
};

typedef int i32x4v __attribute__((ext_vector_type(4)));
typedef int i32x8v __attribute__((ext_vector_type(8)));
DI i32x8v f8cat(bf16x8 lo, bf16x8 hi) { const i32x4v a = __builtin_bit_cast(i32x4v, lo), b = __builtin_bit_cast(i32x4v, hi); return __builtin_shufflevector(a, b, 0, 1, 2, 3, 4, 5, 6, 7); }
DI unsigned cvt_pk_bf16(float lo, float hi) { unsigned r; asm volatile("v_cvt_pk_bf16_f32 %0, %1, %2" : "=v"(r) : "v"(lo), "v"(hi)); return r; }

template <bool F8, bool I32 = false>
struct EpiSwigluT {
    static constexpr bool PERM = true, AFTER_DRAIN = false, MIDK = false;
    bf16_t* act; const float* ss; float ds;
    DI void operator()(const f32x4 (&acc)[2][2][4][2], const Unit& u, int wr, int wc, int fr, int fq) const {
#pragma unroll
        for (int ai = 0; ai < 2; ++ai)
#pragma unroll
            for (int m = 0; m < 4; ++m) {
                const int row = u.pm * BM + ai * HALF + wr * 64 + m * 16 + fr;
                float rs = ds;
                if (ss) { const f32x4 s0 = *(const f32x4*)(ss + (size_t)row * 8), s1 = *(const f32x4*)(ss + (size_t)row * 8 + 4);
                          rs = ds / sqrtf((((s0[0] + s0[1]) + (s0[2] + s0[3])) + ((s1[0] + s1[1]) + (s1[2] + s1[3]))) * (1.0f / 2048.0f) + EPS); }
                float o[8];
#pragma unroll
                for (int n = 0; n < 2; ++n)
#pragma unroll
                    for (int j = 0; j < 4; ++j) { const float g = (I32 ? (float)__float_as_int(acc[ai][0][m][n][j]) : acc[ai][0][m][n][j]) * rs, up = (I32 ? (float)__float_as_int(acc[ai][1][m][n][j]) : acc[ai][1][m][n][j]) * rs; o[4 * n + j] = g * __builtin_amdgcn_rcpf(1.0f + __expf(-g)) * up; }
                if constexpr (F8) {
                    u32x2 w; w.x = pk4_fp8(o[0] * F8_ASCALE, o[1] * F8_ASCALE, o[2] * F8_ASCALE, o[3] * F8_ASCALE); w.y = pk4_fp8(o[4] * F8_ASCALE, o[5] * F8_ASCALE, o[6] * F8_ASCALE, o[7] * F8_ASCALE);
                    *(u32x2*)((unsigned char*)act + (size_t)row * DFF + u.pn * 128 + wc * 32 + 8 * fq) = w;
                } else {
                u32x4 w; w.x = cvt_pk_bf16(o[0], o[1]); w.y = cvt_pk_bf16(o[2], o[3]); w.z = cvt_pk_bf16(o[4], o[5]); w.w = cvt_pk_bf16(o[6], o[7]);
                *(u32x4*)(act + (size_t)row * DFF + u.pn * 128 + wc * 32 + 8 * fq) = w; }
            }
    }
};
using EpiSwiglu = EpiSwigluT<false, true>;
DI f32x4 bf4_to_f32(u32x2 w) { f32x4 r; r[0] = __uint_as_float(w.x << 16); r[1] = __uint_as_float(w.x & 0xffff0000u); r[2] = __uint_as_float(w.y << 16); r[3] = __uint_as_float(w.y & 0xffff0000u); return r; }
struct EpiResid {
    static constexpr bool PERM = false, AFTER_DRAIN = false, MIDK = false;
    const bf16_t* base; float* out; float scale;
    DI void operator()(const f32x4 (&acc)[2][2][4][2], const Unit& u, int wr, int wc, int fr, int fq) const {
        const bf16_t* const base_ = base; float* const out_ = out; const float scale_ = scale; const int pm_ = u.pm, pn_ = u.pn;
#pragma unroll
        for (int ai = 0; ai < 2; ++ai) {
            u32x2 bs[4][2][2];
#pragma unroll
            for (int m = 0; m < 4; ++m) { const size_t off = (size_t)(pm_ * BM + ai * HALF + wr * 64 + m * 16 + fr) * DM + pn_ * BM + wc * 32 + 4 * fq;
#pragma unroll
                for (int bj = 0; bj < 2; ++bj)
#pragma unroll
                    for (int n = 0; n < 2; ++n) bs[m][bj][n] = *(const u32x2*)(base_ + off + bj * HALF + n * 16); }
#pragma unroll
            for (int m = 0; m < 4; ++m) { const size_t off = (size_t)(pm_ * BM + ai * HALF + wr * 64 + m * 16 + fr) * DM + pn_ * BM + wc * 32 + 4 * fq;
#pragma unroll
                for (int bj = 0; bj < 2; ++bj)
#pragma unroll
                    for (int n = 0; n < 2; ++n) *(f32x4*)(out_ + off + bj * HALF + n * 16) = bf4_to_f32(bs[m][bj][n]) + acc[ai][bj][m][n] * scale_; }
            asm volatile("" ::: "memory");
        }
    }
};
template <bool TWO_NORM, bool BASE_BF16>
struct EpiResidStat {
    static constexpr bool PERM = false, AFTER_DRAIN = true, MIDK = TWO_NORM;
    const void* base; float scale; bf16_t* hb; float* ssq; const float* sso; unsigned char* hb8;
    DI void row_norms(int row, float& ra, float& rb) const {
        const f32x4 a0 = *(const f32x4*)(sso + (size_t)row * 16), a1 = *(const f32x4*)(sso + (size_t)row * 16 + 4), b0 = *(const f32x4*)(sso + (size_t)row * 16 + 8), b1 = *(const f32x4*)(sso + (size_t)row * 16 + 12);
        ra = 1.0f / sqrtf((((a0[0] + a0[1]) + (a0[2] + a0[3])) + ((a1[0] + a1[1]) + (a1[2] + a1[3]))) * (1.0f / 1024.0f) + EPS);
        rb = 1.0f / sqrtf((((b0[0] + b0[1]) + (b0[2] + b0[3])) + ((b1[0] + b1[1]) + (b1[2] + b1[3]))) * (1.0f / 1024.0f) + EPS);
    }
    DI void midk(f32x4 (&acc)[2][2][4][2], const Unit& u, int wr, int wc, int fr, int fq) const {
#pragma unroll
        for (int ai = 0; ai < 2; ++ai)
#pragma unroll
            for (int m = 0; m < 4; ++m) { float ra, rb; row_norms(u.pm * BM + ai * HALF + wr * 64 + m * 16 + fr, ra, rb); const float f = ra / rb;
#pragma unroll
                for (int bj = 0; bj < 2; ++bj)
#pragma unroll
                    for (int n = 0; n < 2; ++n) acc[ai][bj][m][n] *= f; }
    }
    DI void fused(f32x4 (&acc)[2][2][4][2], const Unit& u, int wr, int wc, int fr, int fq, PG8_LAS unsigned char* lds, int wid, int lane) const {
        PG8_LAS float* P = (PG8_LAS float*)lds;
        const float* const basef_ = (const float*)base; const bf16_t* const baseh_ = (const bf16_t*)base; bf16_t* const hb_ = hb; unsigned char* const hb8_ = hb8; const float scale_ = scale; float* const ssq_ = ssq; const int pm_ = u.pm, pn_ = u.pn;
#pragma unroll
        for (int ai = 0; ai < 2; ++ai) {
            f32x4 bs[4][2][2];
#pragma unroll
            for (int m = 0; m < 4; ++m) { const size_t off = (size_t)(pm_ * BM + ai * HALF + wr * 64 + m * 16 + fr) * DM + pn_ * BM + wc * 32 + 4 * fq;
#pragma unroll
                for (int bj = 0; bj < 2; ++bj)
#pragma unroll
                    for (int n = 0; n < 2; ++n) { if constexpr (BASE_BF16) bs[m][bj][n] = bf4_to_f32(*(const u32x2*)(baseh_ + off + bj * HALF + n * 16)); else bs[m][bj][n] = *(const f32x4*)(basef_ + off + bj * HALF + n * 16); } }
#pragma unroll
            for (int m = 0; m < 4; ++m) {
                const int rl = ai * HALF + wr * 64 + m * 16 + fr, row = pm_ * BM + rl;
                float f = scale_; if constexpr (TWO_NORM) { float ra, rb; row_norms(row, ra, rb); f = rb; }
                const size_t off = (size_t)row * DM + pn_ * BM + wc * 32 + 4 * fq;
                float q = 0.f;
#pragma unroll
                for (int bj = 0; bj < 2; ++bj)
#pragma unroll
                    for (int n = 0; n < 2; ++n) { const f32x4 v = bs[m][bj][n] + acc[ai][bj][m][n] * f;
                        u32x2 w; w.x = cvt_pk_bf16(v[0], v[1]); w.y = cvt_pk_bf16(v[2], v[3]); *(u32x2*)(hb_ + off + bj * HALF + n * 16) = w;
                        if (hb8_) *(unsigned*)(hb8_ + off + bj * HALF + n * 16) = pk4_i8(v[0] * I8_X2_SCALE, v[1] * I8_X2_SCALE, v[2] * I8_X2_SCALE, v[3] * I8_X2_SCALE);
                        q += (v[0] * v[0] + v[1] * v[1]) + (v[2] * v[2] + v[3] * v[3]); }
                q += __shfl_xor(q, 16); q += __shfl_xor(q, 32);
                if (fq == 0) P[rl * 4 + wc] = q;
            }
            asm volatile("" ::: "memory");
        }
        asm volatile("s_waitcnt lgkmcnt(0)" ::: "memory"); __builtin_amdgcn_s_barrier(); asm volatile("" ::: "memory");
        const int tid = wid * 64 + lane;
        if (tid < 256) { const f32x4 pp = *(const PG8_LAS f32x4*)(P + tid * 4); ssq_[(size_t)(pm_ * BM + tid) * 8 + pn_] = (pp[0] + pp[1]) + (pp[2] + pp[3]); }
        asm volatile("s_waitcnt lgkmcnt(0)" ::: "memory"); __builtin_amdgcn_s_barrier(); asm volatile("" ::: "memory");
    }
};
struct EpiNull {
    static constexpr bool PERM = true, AFTER_DRAIN = false, MIDK = false;
    DI void operator()(const f32x4 (&acc)[2][2][4][2], const Unit& u, int wr, int wc, int fr, int fq) const {
#pragma unroll
        for (int ai = 0; ai < 2; ++ai)
#pragma unroll
            for (int bj = 0; bj < 2; ++bj)
#pragma unroll
                for (int m = 0; m < 4; ++m)
#pragma unroll
                    for (int n = 0; n < 2; ++n) asm volatile("" :: "v"(acc[ai][bj][m][n]));
    }
};
template <int NSS> DI float row_rs(const float* ss, int row, float invn) {
    float t = 0.f;
#pragma unroll
    for (int i = 0; i < NSS / 4; ++i) { const f32x4 q = *(const f32x4*)(ss + (size_t)row * NSS + 4 * i); t += (q[0] + q[1]) + (q[2] + q[3]); }
    return 1.0f / sqrtf(t * invn + EPS);
}
struct EpiBf16 {
    static constexpr bool PERM = true, AFTER_DRAIN = false, MIDK = false;
    bf16_t* O; int ldc; const float* ss;
    DI void operator()(const f32x4 (&acc)[2][2][4][2], const Unit& u, int wr, int wc, int fr, int fq) const {
#pragma unroll
        for (int ai = 0; ai < 2; ++ai)
#pragma unroll
            for (int m = 0; m < 4; ++m) {
                const int row = u.pm * BM + ai * HALF + wr * 64 + m * 16 + fr;
                const float rs = ss ? row_rs<12>(ss, row, 1.0f / 384.0f) : 1.0f;
                bf16_t* rowp = O + (size_t)row * ldc + u.pn * BM + wc * 32 + 8 * fq;
#pragma unroll
                for (int bj = 0; bj < 2; ++bj) { const f32x4 v0 = acc[ai][bj][m][0] * rs, v1 = acc[ai][bj][m][1] * rs;
                    u32x4 w; w.x = cvt_pk_bf16(v0[0], v0[1]); w.y = cvt_pk_bf16(v0[2], v0[3]); w.z = cvt_pk_bf16(v1[0], v1[1]); w.w = cvt_pk_bf16(v1[2], v1[3]);
                    *(u32x4*)(rowp + bj * HALF) = w; }
            }
    }
};
DI u32x4 pack8(const f32x4 a, const f32x4 b) { u32x4 w; w.x = cvt_pk_bf16(a[0], a[1]); w.y = cvt_pk_bf16(a[2], a[3]); w.z = cvt_pk_bf16(b[0], b[1]); w.w = cvt_pk_bf16(b[2], b[3]); return w; }
struct EpiProj {
    static constexpr bool PERM = true, AFTER_DRAIN = false, MIDK = false;
    unsigned char* ws; const float *qg, *kg; PG8_LAS float* P;
    DI void operator()(const f32x4 (&acc)[2][2][4][2], const Unit& u, int wr, int wc, int fr, int fq) const {
        const float* const ss = (const float*)(ws + WS_SS);
        bf16_t* const qn = (bf16_t*)(ws + WS_QN); bf16_t* const kcmp = (bf16_t*)(ws + WS_KCMP); bf16_t* const vcmp = (bf16_t*)(ws + WS_VCMP); bf16_t* const ks = (bf16_t*)(ws + WS_KS); bf16_t* const vs = (bf16_t*)(ws + WS_VS);
        bf16_t* const kw = (bf16_t*)(ws + WS_KW); bf16_t* const vw = (bf16_t*)(ws + WS_VW); bf16_t* const cq = (bf16_t*)(ws + WS_CQ); bf16_t* const ckv = (bf16_t*)(ws + WS_CKV);
        float* const krope = (float*)(ws + WS_KROPE); float* const gates = (float*)(ws + WS_GATES); float* const ssq_cq = (float*)(ws + WS_SSQCQ); float* const ssq_ckv = (float*)(ws + WS_SSQCKV);
        asm volatile("" : "+v"(fr), "+v"(fq));
        const int pn = u.pn, c8 = wc * 32 + 8 * fq;
        const bool norm2 = pn < 4 || pn == 6 || pn == 8;
        if (norm2) {
#pragma unroll
            for (int ai = 0; ai < 2; ++ai)
#pragma unroll
                for (int m = 0; m < 4; ++m) { const int rl = ai * HALF + wr * 64 + m * 16 + fr; const float rs = row_rs<8>(ss, u.pm * BM + rl, 1.0f / 2048.0f);
#pragma unroll
                    for (int bj = 0; bj < 2; ++bj) { const f32x4 a = acc[ai][bj][m][0] * rs, b = acc[ai][bj][m][1] * rs;
                        float q = ((a[0] * a[0] + a[1] * a[1]) + (a[2] * a[2] + a[3] * a[3])) + ((b[0] * b[0] + b[1] * b[1]) + (b[2] * b[2] + b[3] * b[3]));
                        q += __shfl_xor(q, 16); q += __shfl_xor(q, 32);
                        if (fq == 0) P[(rl * 2 + bj) * 4 + wc] = q; } }
            asm volatile("s_waitcnt lgkmcnt(0)" ::: "memory"); __builtin_amdgcn_s_barrier(); asm volatile("" ::: "memory");
            const float* gp = (pn < 4 ? qg : (pn == 6 ? kg + 128 : kg + 256)) + c8;
            const f32x4 g0 = *(const f32x4*)gp, g1 = *(const f32x4*)(gp + 4);
#pragma unroll
            for (int ai = 0; ai < 2; ++ai)
#pragma unroll
                for (int m = 0; m < 4; ++m) { const int rl = ai * HALF + wr * 64 + m * 16 + fr, row = u.pm * BM + rl, b = row >> 11, sq = row & 2047; const float rs = row_rs<8>(ss, row, 1.0f / 2048.0f);
#pragma unroll
                    for (int bj = 0; bj < 2; ++bj) { const f32x4 pp = *(const PG8_LAS f32x4*)(P + (rl * 2 + bj) * 4);
                        const float f = rs / sqrtf(((pp[0] + pp[1]) + (pp[2] + pp[3])) * (1.0f / 128.0f) + EPS);
                        const u32x4 w = pack8(acc[ai][bj][m][0] * f * g0, acc[ai][bj][m][1] * f * g1);
                        bf16_t* dst = pn < 4 ? qn + (size_t)row * 1024 + pn * 256 + bj * 128 + c8 : (pn == 6 ? ks : kw) + (((size_t)b * 2 + bj) * SEQ + sq) * 128 + c8;
                        *(u32x4*)dst = w; } }
            return;
        }
#pragma unroll
        for (int ai = 0; ai < 2; ++ai)
#pragma unroll
            for (int m = 0; m < 4; ++m) {
                const int row = u.pm * BM + ai * HALF + wr * 64 + m * 16 + fr, b = row >> 11, sq = row & 2047; const float rs = row_rs<8>(ss, row, 1.0f / 2048.0f);
#pragma unroll
                for (int bj = 0; bj < 2; ++bj) {
                    const f32x4 a = acc[ai][bj][m][0] * rs, c = acc[ai][bj][m][1] * rs;
                    if (pn == 4 || pn == 5) { *(u32x4*)((pn == 4 ? kcmp : vcmp) + (((size_t)bj * NB + b) * SEQ + sq) * 128 + c8) = pack8(a, c); }
                    else if (pn == 7 || pn == 9) { *(u32x4*)((pn == 7 ? vs : vw) + (((size_t)b * 2 + bj) * SEQ + sq) * 128 + c8) = pack8(a, c); }
                    else if (pn == 10 || (pn == 11 && bj == 0) || pn == 12) {
                        float q = ((a[0] * a[0] + a[1] * a[1]) + (a[2] * a[2] + a[3] * a[3])) + ((c[0] * c[0] + c[1] * c[1]) + (c[2] * c[2] + c[3] * c[3]));
                        q += __shfl_xor(q, 16); q += __shfl_xor(q, 32);
                        if (pn == 12) { *(u32x4*)(ckv + (size_t)row * 256 + bj * 128 + c8) = pack8(a, c); if (fq == 0) ssq_ckv[(size_t)row * 8 + bj * 4 + wc] = q; }
                        else { const int ch = (pn - 10) * 2 + bj; *(u32x4*)(cq + (size_t)row * 384 + ch * 128 + c8) = pack8(a, c); if (fq == 0) ssq_cq[(size_t)row * 12 + ch * 4 + wc] = q; }
                    } else {
                        float qk = ((a[0] * a[0] + a[1] * a[1]) + (a[2] * a[2] + a[3] * a[3])) + ((c[0] * c[0] + c[1] * c[1]) + (c[2] * c[2] + c[3] * c[3]));
                        qk += __shfl_xor(qk, 16); qk += __shfl_xor(qk, 32);
                        if (wc < 2) { *(f32x4*)(krope + (size_t)row * 64 + c8) = a; *(f32x4*)(krope + (size_t)row * 64 + c8 + 4) = c; if (fq == 0) ((float*)(ws + WS_SSQKR))[(size_t)row * 2 + wc] = qk; }
                        else if (wc == 2 && fq < 3) { f32x4 ga, gc;
#pragma unroll
                            for (int j = 0; j < 4; ++j) { ga[j] = 1.0f / (1.0f + __expf(-a[j])); gc[j] = 1.0f / (1.0f + __expf(-c[j])); }
                            *(f32x4*)(gates + (size_t)row * 24 + 8 * fq) = ga; *(f32x4*)(gates + (size_t)row * 24 + 8 * fq + 4) = gc; }
                    }
                }
            }
    }
};
struct EpiKV {
    static constexpr bool PERM = true, AFTER_DRAIN = false, MIDK = false;
    unsigned char* ws; const float* kgain; PG8_LAS float* P;
    DI void operator()(const f32x4 (&acc)[2][2][4][2], const Unit& u, int wr, int wc, int fr, int fq) const {
        const float* const ss = (const float*)(ws + WS_SSQCKV); const float* const ssk = (const float*)(ws + WS_SSQKR);
        bf16_t* const km = (bf16_t*)(ws + WS_KM); bf16_t* const vm = (bf16_t*)(ws + WS_VM);
        PG8_LAS float* const Rt = P + 1024;
        asm volatile("" : "+v"(fr), "+v"(fq));
        const int h = u.pn, c8 = wc * 32 + 8 * fq;
#pragma unroll
        for (int ai = 0; ai < 2; ++ai)
#pragma unroll
            for (int m = 0; m < 4; ++m) { const int rl = ai * HALF + wr * 64 + m * 16 + fr; const float rs = row_rs<8>(ss, u.pm * BM + rl, 1.0f / 256.0f);
                const f32x4 a = acc[ai][0][m][0] * rs, b = acc[ai][0][m][1] * rs;
                float q = ((a[0] * a[0] + a[1] * a[1]) + (a[2] * a[2] + a[3] * a[3])) + ((b[0] * b[0] + b[1] * b[1]) + (b[2] * b[2] + b[3] * b[3]));
                q += __shfl_xor(q, 16); q += __shfl_xor(q, 32);
                if (fq == 0) P[rl * 4 + wc] = q; }
        asm volatile("s_waitcnt lgkmcnt(0)" ::: "memory"); __builtin_amdgcn_s_barrier(); asm volatile("" ::: "memory");
        const f32x4 g0 = *(const f32x4*)(kgain + c8), g1 = *(const f32x4*)(kgain + c8 + 4);
#pragma unroll
        for (int ai = 0; ai < 2; ++ai)
#pragma unroll
            for (int m = 0; m < 4; ++m) { const int rl = ai * HALF + wr * 64 + m * 16 + fr, row = u.pm * BM + rl, b = row >> 11, sq = row & 2047; const float rs = row_rs<8>(ss, row, 1.0f / 256.0f);
                const f32x4 pp = *(const PG8_LAS f32x4*)(P + rl * 4); const f32x2 kk = *(const f32x2*)(ssk + (size_t)row * 2);
                const float rh = 1.0f / sqrtf((((pp[0] + pp[1]) + (pp[2] + pp[3])) + (kk.x + kk.y)) * (1.0f / 192.0f) + EPS);
                if (wc == 0 && fq == 0) Rt[rl] = rh;
                const float f = rs * rh;
                *(u32x4*)(km + (((size_t)b * 8 + h) * SEQ + sq) * 192 + c8) = pack8(acc[ai][0][m][0] * f * g0, acc[ai][0][m][1] * f * g1);
                *(u32x4*)(vm + (((size_t)b * 8 + h) * SEQ + sq) * 128 + c8) = pack8(acc[ai][1][m][0] * rs, acc[ai][1][m][1] * rs);
                asm volatile("" ::: "memory"); }
        asm volatile("s_waitcnt lgkmcnt(0)" ::: "memory"); __builtin_amdgcn_s_barrier(); asm volatile("" ::: "memory");
        {
            const int tid = (wr * 4 + wc) * 64 + fq * 16 + fr, rl2 = tid >> 1, i0 = (tid & 1) * 16, row = u.pm * BM + rl2, b = row >> 11, sq = row & 2047;
            const float rh = Rt[rl2];
            const float* kr = (const float*)(ws + WS_KROPE) + (size_t)row * 64; const float* rp = (const float*)(ws + WS_ROPE) + ((size_t)sq * 32 + i0) * 2;
            bf16_t* ko = km + (((size_t)b * 8 + h) * SEQ + sq) * 192 + 128;
            u32x4 w1[2], w2[2];
#pragma unroll
            for (int v4 = 0; v4 < 2; ++v4) {
                float o1[8], o2[8];
#pragma unroll
                for (int e = 0; e < 2; ++e) { const int i = i0 + 8 * v4 + 4 * e;
                    const f32x4 x1 = *(const f32x4*)(kr + i), x2 = *(const f32x4*)(kr + 32 + i), ga = *(const f32x4*)(kgain + 128 + i), gb = *(const f32x4*)(kgain + 160 + i);
                    const f32x4 cs0 = *(const f32x4*)(rp + (8 * v4 + 4 * e) * 2), cs1 = *(const f32x4*)(rp + (8 * v4 + 4 * e) * 2 + 4);
#pragma unroll
                    for (int j = 0; j < 4; ++j) { const float a = x1[j] * rh * ga[j], c = x2[j] * rh * gb[j]; const float co = j < 2 ? cs0[2 * j] : cs1[2 * (j - 2)], si = j < 2 ? cs0[2 * j + 1] : cs1[2 * (j - 2) + 1];
                        o1[4 * e + j] = a * co - c * si; o2[4 * e + j] = c * co + a * si; } }
                w1[v4].x = cvt_pk_bf16(o1[0], o1[1]); w1[v4].y = cvt_pk_bf16(o1[2], o1[3]); w1[v4].z = cvt_pk_bf16(o1[4], o1[5]); w1[v4].w = cvt_pk_bf16(o1[6], o1[7]);
                w2[v4].x = cvt_pk_bf16(o2[0], o2[1]); w2[v4].y = cvt_pk_bf16(o2[2], o2[3]); w2[v4].z = cvt_pk_bf16(o2[4], o2[5]); w2[v4].w = cvt_pk_bf16(o2[6], o2[7]);
            }
            *(u32x4*)(ko + i0) = w1[0]; *(u32x4*)(ko + i0 + 8) = w1[1]; *(u32x4*)(ko + 32 + i0) = w2[0]; *(u32x4*)(ko + 32 + i0 + 8) = w2[1];
        }
    }
};
struct EpiSlab {
    static constexpr bool PERM = false, AFTER_DRAIN = false, MIDK = false;
    float* slab;
    DI void operator()(const f32x4 (&acc)[2][2][4][2], const Unit& u, int wr, int wc, int fr, int fq) const {
        float* s = slab + (size_t)u.aux * 512 * 256;
#pragma unroll
        for (int ai = 0; ai < 2; ++ai)
#pragma unroll
            for (int m = 0; m < 4; ++m) {
                float* rowp = s + (size_t)(u.pm * BM + ai * HALF + wr * 64 + m * 16 + fr) * 256 + wc * 32 + 4 * fq;
#pragma unroll
                for (int bj = 0; bj < 2; ++bj)
#pragma unroll
                    for (int n = 0; n < 2; ++n) *(f32x4*)(rowp + bj * HALF + n * 16) = acc[ai][bj][m][n];
            }
    }
};

struct EpiP6 {
    static constexpr bool PERM = true, AFTER_DRAIN = false, MIDK = false;
    EpiBf16 eq; EpiKV ekv; EpiSlab es;
    DI void operator()(const f32x4 (&acc)[2][2][4][2], const Unit& u, int wr, int wc, int fr, int fq) const {
        if (u.type == 0) eq(acc, u, wr, wc, fr, fq); else if (u.type == 1) ekv(acc, u, wr, wc, fr, fq); else es(acc, u, wr, wc, fr, fq);
    }
};
template <class Epi, class Sched, bool ALIGN_EPI, bool MULTI = false, int DBG = 0, int QM = 0>
DI void gemm_phase(PG8_LAS unsigned char* lds, const Gemm g, const Sched& S, const Epi& E) {
    constexpr bool F8 = (QM == 1);
    int tid = threadIdx.x; asm volatile("" : "+v"(tid));
    const int wid = __builtin_amdgcn_readfirstlane(tid >> 6), lane = tid & 63, wr = wid >> 2, wc = wid & 3, fr = lane & 15, fq = lane >> 4;
    int K = g.K; asm volatile("" : "+s"(K)); int nt = K / BK;
    unsigned voffA[2], voffB[2];
#pragma unroll
    for (int i = 0; i < 2; ++i) { int R, C; stage_rc(tid * 16 + i * 8192, R, C); const int Rb = Epi::PERM ? ((R & ~31) + perm32(R & 31)) : R;
        voffA[i] = (unsigned)(R * g.lda + C) * 2u; voffB[i] = (unsigned)(Rb * g.ldb + C) * 2u; }
    const size_t kstep = (size_t)(BK * 2);
    size_t hstepA = (size_t)HALF * g.lda * 2, hstepB = (size_t)HALF * g.ldb * 2;
#define PG8_GEOM(u_, va_, vb_, ha_, hb_) do { const int la_ = mg_lda((u_).type), lb_ = mg_ldb((u_).type), pe_ = mg_perm((u_).type); _Pragma("unroll") for (int i_ = 0; i_ < 2; ++i_) { int R_, C_; stage_rc(tid * 16 + i_ * 8192, R_, C_); const int Rb_ = pe_ ? ((R_ & ~31) + perm32(R_ & 31)) : R_; \
        va_[i_] = (unsigned)(R_ * la_ + C_ * 2); vb_[i_] = (unsigned)(Rb_ * lb_ + C_ * 2); } ha_ = (size_t)HALF * la_; hb_ = (size_t)HALF * lb_; } while (0)
    const unsigned ldsw = (unsigned)wid * 1024u;
    const int aoff = lds_byte(wr * 64 + fr, fq * 8), boff = lds_byte(wc * 32 + fr, fq * 8);
#define PG8_SA(b, h) (((b) * 2 + (h)) * HTB)
#define PG8_SB(b, h) ((4 + (b) * 2 + (h)) * HTB)
#define PG8_STAGE(bufoff, gbase, voff) do { if constexpr (DBG != 2) _Pragma("unroll") for (int _i = 0; _i < 2; ++_i) { unsigned vo_ = (voff)[_i]; asm volatile("" : "+v"(vo_)); \
        __builtin_amdgcn_global_load_lds((const unsigned*)((const char*)(gbase) + vo_), (PG8_LAS unsigned*)(lds + (bufoff) + ldsw + _i * 8192), 16, 0, 0); } } while (0)
#define PG8_LDA(dst, b, h) do { _Pragma("unroll") for (int m = 0; m < 4; ++m) _Pragma("unroll") for (int k = 0; k < 2; ++k) dst[m][k] = *(const PG8_LAS bf16x8*)(lds + PG8_SA(b, h) + aoff + m * 2048 + k * 1024); } while (0)
#define PG8_LDB(dst, b, h) do { _Pragma("unroll") for (int n = 0; n < 2; ++n) _Pragma("unroll") for (int k = 0; k < 2; ++k) dst[n][k] = *(const PG8_LAS bf16x8*)(lds + PG8_SB(b, h) + boff + n * 2048 + k * 1024); } while (0)
#define PG8_MMA(ai, bj, At, Bt) do { __builtin_amdgcn_s_setprio(1); if constexpr (DBG == 1) { _Pragma("unroll") for (int m = 0; m < 4; ++m) _Pragma("unroll") for (int k = 0; k < 2; ++k) asm volatile("" :: "v"(At[m][k])); _Pragma("unroll") for (int n = 0; n < 2; ++n) _Pragma("unroll") for (int k = 0; k < 2; ++k) asm volatile("" :: "v"(Bt[n][k])); } \
        if constexpr (DBG != 1 && F8) _Pragma("unroll") for (int m = 0; m < 4; ++m) _Pragma("unroll") for (int n = 0; n < 2; ++n) \
        acc[ai][bj][m][n] = __builtin_amdgcn_mfma_scale_f32_16x16x128_f8f6f4(f8cat(Bt[n][0], Bt[n][1]), f8cat(At[m][0], At[m][1]), acc[ai][bj][m][n], 0, 0, 0, 0, 0, 0); \
        if constexpr (DBG != 1 && QM == 2) _Pragma("unroll") for (int m = 0; m < 4; ++m) _Pragma("unroll") for (int n = 0; n < 2; ++n) _Pragma("unroll") for (int k = 0; k < 2; ++k) \
        acc[ai][bj][m][n] = __builtin_bit_cast(f32x4, __builtin_amdgcn_mfma_i32_16x16x64_i8(__builtin_bit_cast(i32x4v, Bt[n][k]), __builtin_bit_cast(i32x4v, At[m][k]), __builtin_bit_cast(i32x4v, acc[ai][bj][m][n]), 0, 0, 0)); \
        if constexpr (DBG != 1 && QM == 0) _Pragma("unroll") for (int m = 0; m < 4; ++m) _Pragma("unroll") for (int n = 0; n < 2; ++n) _Pragma("unroll") for (int k = 0; k < 2; ++k) \
        acc[ai][bj][m][n] = __builtin_amdgcn_mfma_f32_16x16x32_bf16(Bt[n][k], At[m][k], acc[ai][bj][m][n], 0, 0, 0); __builtin_amdgcn_s_setprio(0); } while (0)
#define PG8_WAIT_V(n) asm volatile("s_waitcnt vmcnt(" #n ")" ::: "memory")
#define PG8_WAIT_L(n) asm volatile("s_waitcnt lgkmcnt(" #n ")" ::: "memory")
#define PG8_BAR __builtin_amdgcn_s_barrier()
#define PG8_SCHED __builtin_amdgcn_sched_barrier(0)
    Unit cur, nxt; int ui = 0;
    if (!S.next(0, cur)) return;
    f32x4 acc[2][2][4][2];
#pragma unroll
    for (int a = 0; a < 2; ++a)
#pragma unroll
        for (int b = 0; b < 2; ++b)
#pragma unroll
            for (int m = 0; m < 4; ++m)
#pragma unroll
                for (int n = 0; n < 2; ++n) acc[a][b][m][n] = (f32x4){0.f, 0.f, 0.f, 0.f};
    bf16x8 At[4][2], B0[2][2], B1[2][2];
    const char* cA = cur.A; const char* cB = cur.B;
    if constexpr (MULTI) { PG8_GEOM(cur, voffA, voffB, hstepA, hstepB); nt = mg_nt(cur.type); }
#if PG8_SP2 == 2
    PG8_STAGE(PG8_SB(0, 0), cB, voffB); PG8_STAGE(PG8_SB(0, 1), cB + hstepB, voffB); PG8_STAGE(PG8_SA(0, 0), cA, voffA); PG8_STAGE(PG8_SA(0, 1), cA + hstepA, voffA);
    PG8_STAGE(PG8_SB(1, 0), cB + kstep, voffB); PG8_STAGE(PG8_SB(1, 1), cB + hstepB + kstep, voffB);
    if (wr == 1) PG8_BAR;
    PG8_WAIT_V(6); PG8_BAR; PG8_BAR;
#elif PG8_SP2
    PG8_STAGE(PG8_SB(0, 0), cB, voffB); PG8_STAGE(PG8_SB(0, 1), cB + hstepB, voffB); PG8_STAGE(PG8_SA(0, 0), cA, voffA); PG8_STAGE(PG8_SA(0, 1), cA + hstepA, voffA);
    if (wr == 1) PG8_BAR;
    PG8_WAIT_V(2); PG8_BAR;
#else
    PG8_STAGE(PG8_SB(0, 0), cB, voffB); PG8_STAGE(PG8_SA(0, 0), cA, voffA); PG8_STAGE(PG8_SB(0, 1), cB + hstepB, voffB); PG8_STAGE(PG8_SA(0, 1), cA + hstepA, voffA);
    if (wr == 1) PG8_BAR;
    PG8_WAIT_V(4); PG8_BAR;
#endif
#if PG8_SP2 != 2
    PG8_STAGE(PG8_SB(1, 0), cB + kstep, voffB); PG8_STAGE(PG8_SA(1, 0), cA + kstep, voffA); PG8_STAGE(PG8_SB(1, 1), cB + hstepB + kstep, voffB);
    PG8_WAIT_V(6); PG8_BAR;
#endif
    for (;;) {
        const bool has_next = S.next(ui + 1, nxt);
        const char* nA = has_next ? nxt.A : cA; const char* nB = has_next ? nxt.B : cB;
#pragma unroll 1
        for (int t = 0; t < nt; t += 2) {
            const bool last = (t == nt - 2);
            const char* a1 = cA + (size_t)(t + 1) * kstep;
            const char* a2 = last ? nA : cA + (size_t)(t + 2) * kstep; const char* b2 = last ? nB : cB + (size_t)(t + 2) * kstep;
            const char* a3 = a2 + kstep; const char* b3 = b2 + kstep;
            unsigned svA[2], svB[2]; size_t shA, shB;
            svA[0] = voffA[0]; svA[1] = voffA[1]; svB[0] = voffB[0]; svB[1] = voffB[1]; shA = hstepA; shB = hstepB;
            if constexpr (MULTI) { if (last && has_next) PG8_GEOM(nxt, svA, svB, shA, shB); }
            if constexpr (Epi::MIDK) { if (t == (nt >> 1)) E.midk(acc, cur, wr, wc, fr, fq); }
#if PG8_SP2 == 2
            PG8_LDB(B0, 0, 0); PG8_LDB(B1, 0, 1); PG8_SCHED; PG8_LDA(At, 0, 0); PG8_STAGE(PG8_SA(1, 0), a1, voffA); PG8_STAGE(PG8_SA(1, 1), a1 + hstepA, voffA);
            PG8_WAIT_V(8); PG8_WAIT_L(0); PG8_BAR; PG8_MMA(0, 0, At, B0); PG8_MMA(0, 1, At, B1); PG8_BAR; PG8_SCHED;
            PG8_LDA(At, 0, 1); PG8_STAGE(PG8_SB(0, 0), b2, svB); PG8_STAGE(PG8_SB(0, 1), b2 + shB, svB);
            PG8_WAIT_V(6); PG8_WAIT_L(0); PG8_BAR; PG8_MMA(1, 0, At, B0); PG8_MMA(1, 1, At, B1); PG8_BAR; PG8_SCHED;
            PG8_LDB(B0, 1, 0); PG8_LDB(B1, 1, 1); PG8_SCHED; PG8_LDA(At, 1, 0); PG8_STAGE(PG8_SA(0, 0), a2, svA); PG8_STAGE(PG8_SA(0, 1), a2 + shA, svA);
            PG8_WAIT_V(8); PG8_WAIT_L(0); PG8_BAR; PG8_MMA(0, 0, At, B0); PG8_MMA(0, 1, At, B1); PG8_BAR; PG8_SCHED;
            PG8_LDA(At, 1, 1); PG8_STAGE(PG8_SB(1, 0), b3, svB); PG8_STAGE(PG8_SB(1, 1), b3 + shB, svB);
            PG8_WAIT_V(6); PG8_WAIT_L(0); PG8_BAR; PG8_MMA(1, 0, At, B0); PG8_MMA(1, 1, At, B1); PG8_BAR; PG8_SCHED;
#elif PG8_SP2
            PG8_LDB(B0, 0, 0); PG8_LDB(B1, 0, 1); PG8_SCHED; PG8_LDA(At, 0, 0); PG8_STAGE(PG8_SA(1, 1), a1 + hstepA, voffA);
            PG8_WAIT_V(8); PG8_WAIT_L(0); PG8_BAR; PG8_MMA(0, 0, At, B0); PG8_MMA(0, 1, At, B1); PG8_BAR; PG8_SCHED;
            PG8_LDA(At, 0, 1); PG8_STAGE(PG8_SB(0, 0), b2, svB); PG8_STAGE(PG8_SB(0, 1), b2 + shB, svB); PG8_STAGE(PG8_SA(0, 0), a2, svA);
            PG8_WAIT_V(8); PG8_WAIT_L(0); PG8_BAR; PG8_MMA(1, 0, At, B0); PG8_MMA(1, 1, At, B1); PG8_BAR; PG8_SCHED;
            PG8_LDB(B0, 1, 0); PG8_LDB(B1, 1, 1); PG8_SCHED; PG8_LDA(At, 1, 0); PG8_STAGE(PG8_SA(0, 1), a2 + shA, svA);
            PG8_WAIT_V(8); PG8_WAIT_L(0); PG8_BAR; PG8_MMA(0, 0, At, B0); PG8_MMA(0, 1, At, B1); PG8_BAR; PG8_SCHED;
            PG8_LDA(At, 1, 1); PG8_STAGE(PG8_SB(1, 0), b3, svB); PG8_STAGE(PG8_SB(1, 1), b3 + shB, svB); PG8_STAGE(PG8_SA(1, 0), a3, svA);
            PG8_WAIT_V(8); PG8_WAIT_L(0); PG8_BAR; PG8_MMA(1, 0, At, B0); PG8_MMA(1, 1, At, B1); PG8_BAR; PG8_SCHED;
#else
            PG8_LDB(B0, 0, 0); PG8_SCHED; PG8_LDA(At, 0, 0); PG8_STAGE(PG8_SA(1, 1), a1 + hstepA, voffA);
            PG8_WAIT_L(8); PG8_BAR; PG8_WAIT_L(0); PG8_MMA(0, 0, At, B0); PG8_BAR; PG8_SCHED;
            PG8_LDB(B1, 0, 1); PG8_STAGE(PG8_SB(0, 0), b2, voffB);
            PG8_BAR; PG8_WAIT_L(0); PG8_MMA(0, 1, At, B1); PG8_BAR;
            PG8_LDA(At, 0, 1); PG8_STAGE(PG8_SA(0, 0), a2, voffA);
            PG8_BAR; PG8_WAIT_L(0); PG8_MMA(1, 0, At, B0); PG8_BAR; PG8_SCHED;
            PG8_STAGE(PG8_SB(0, 1), b2 + hstepB, voffB);
            PG8_WAIT_V(6); PG8_BAR; PG8_MMA(1, 1, At, B1); PG8_BAR;
            PG8_LDB(B0, 1, 0); PG8_SCHED; PG8_LDA(At, 1, 0); PG8_STAGE(PG8_SA(0, 1), a2 + hstepA, voffA);
            PG8_WAIT_L(8); PG8_BAR; PG8_WAIT_L(0); PG8_MMA(0, 0, At, B0); PG8_BAR; PG8_SCHED;
            PG8_LDB(B1, 1, 1); PG8_STAGE(PG8_SB(1, 0), b3, voffB);
            PG8_BAR; PG8_WAIT_L(0); PG8_MMA(0, 1, At, B1); PG8_BAR;
            PG8_LDA(At, 1, 1); PG8_STAGE(PG8_SA(1, 0), a3, voffA);
            PG8_BAR; PG8_WAIT_L(0); PG8_MMA(1, 0, At, B0); PG8_BAR; PG8_SCHED;
            PG8_STAGE(PG8_SB(1, 1), b3 + hstepB, voffB);
            PG8_WAIT_V(6); PG8_BAR; PG8_MMA(1, 1, At, B1); PG8_BAR;
#endif
        }
        if constexpr (ALIGN_EPI) { if (wr == 0) PG8_BAR; }
        if constexpr (!Epi::AFTER_DRAIN) { if constexpr (F8) { int t3; asm volatile("v_mbcnt_lo_u32_b32 %0, -1, 0\n\tv_mbcnt_hi_u32_b32 %0, -1, %0" : "=v"(t3)); E(acc, cur, wr, wc, t3 & 15, t3 >> 4); }
            else E(acc, cur, wr, wc, fr, fq); }
        if (!has_next) break;
#pragma unroll
        for (int a = 0; a < 2; ++a)
#pragma unroll
            for (int b = 0; b < 2; ++b)
#pragma unroll
                for (int m = 0; m < 4; ++m)
#pragma unroll
                    for (int n = 0; n < 2; ++n) acc[a][b][m][n] = (f32x4){0.f, 0.f, 0.f, 0.f};
        cur = nxt; cA = nA; cB = nB; ++ui;
        if constexpr (MULTI) { PG8_GEOM(cur, voffA, voffB, hstepA, hstepB); nt = mg_nt(cur.type); }
        if constexpr (ALIGN_EPI) { if (wr == 1) PG8_BAR; }
    }
    PG8_WAIT_V(0);
    if constexpr (!ALIGN_EPI) { if (wr == 0) PG8_BAR; }
    PG8_BAR;
    if constexpr (Epi::AFTER_DRAIN) E.fused(acc, cur, wr, wc, fr, fq, lds, wid, lane);
#undef PG8_GEOM
#undef PG8_SA
#undef PG8_SB
#undef PG8_STAGE
#undef PG8_LDA
#undef PG8_LDB
#undef PG8_MMA
#undef PG8_WAIT_V
#undef PG8_WAIT_L
#undef PG8_BAR
#undef PG8_SCHED
}
}

namespace att {
typedef float f32x16 __attribute__((ext_vector_type(16)));
typedef short s16x4 __attribute__((ext_vector_type(4)));
#define KSWZ(row, colB) ((row) * 256 + ((colB) ^ (((row) & 7) << 4)))
#define SBAR() __builtin_amdgcn_sched_barrier(0)
constexpr int L_V = 0, L_K = 16384, L_KR = 32768, L_WS = 40960, L_MAIN = 43008, L_LAST = L_MAIN + 33792, L_IMP = L_LAST + 33792, L_SELB = L_IMP + 8448, L_ANY = L_SELB + 512, L_END = L_ANY + 16;
static_assert(L_END <= LDS_BYTES, "attention LDS map");
DI int v_st(int k, int c) { const int kk = (k & ~0xC) | ((k & 4) << 1) | ((k & 8) >> 1); return ((kk >> 3) * 4 + (c >> 5)) * 512 + ((kk & 7) * 32 + (c & 31)) * 2; }
DI int v_rd_base(int lane) { return ((lane & 3) << 3) | (((lane >> 2) & 3) << 6) | (((lane >> 4) & 1) << 5) | (((lane >> 5) & 1) << 8); }
constexpr int v_rd_off(int d0, int ks, int half) { return d0 * 512 + ks * 4096 + half * 2048; }
DI int crow(int r, int hi) { return (r & 3) + 8 * (r >> 2) + 4 * hi; }
DI unsigned cvtpk(float lo, float hi) { unsigned r; asm volatile("v_cvt_pk_bf16_f32 %0, %1, %2" : "=v"(r) : "v"(lo), "v"(hi)); return r; }

DI void mask_range(f32x16& p0, f32x16& p1, int lo, int hiB) {
    const float NEG = -__builtin_inff(); const unsigned w = hiB > lo ? (unsigned)(hiB - lo) : 0u;
#pragma unroll
    for (int r = 0; r < 16; ++r) { const int c = (r & 3) + 8 * (r >> 2);
        if ((unsigned)(c - lo) >= w) p0[r] = NEG;
        if ((unsigned)(c + 32 - lo) >= w) p1[r] = NEG; }
}
DI void softmax_tile(f32x16& p0, f32x16& p1, float& m, float& l, float c1, float& alpha) {
    float pmax = p0[0];
#pragma unroll
    for (int r = 1; r < 16; ++r) pmax = fmaxf(pmax, p0[r]);
#pragma unroll
    for (int r = 0; r < 16; ++r) pmax = fmaxf(pmax, p1[r]);
    { auto rr = __builtin_amdgcn_permlane32_swap(__float_as_uint(pmax), __float_as_uint(pmax), false, false); pmax = fmaxf(__uint_as_float(rr[0]), __uint_as_float(rr[1])); }
    float mn;
    if (__all((pmax - m) * c1 <= 8.0f)) { mn = m; alpha = 1.0f; }
    else { mn = fmaxf(m, pmax); alpha = __builtin_amdgcn_exp2f((m - mn) * c1); m = mn; }
    const float mnL = -mn * c1;
#pragma unroll
    for (int r = 0; r < 16; ++r) p0[r] = __builtin_amdgcn_exp2f(fmaf(p0[r], c1, mnL));
#pragma unroll
    for (int r = 0; r < 16; ++r) p1[r] = __builtin_amdgcn_exp2f(fmaf(p1[r], c1, mnL));
    float ps = 0.f;
#pragma unroll
    for (int r = 0; r < 16; ++r) ps += p0[r];
#pragma unroll
    for (int r = 0; r < 16; ++r) ps += p1[r];
    { auto rr = __builtin_amdgcn_permlane32_swap(__float_as_uint(ps), __float_as_uint(ps), false, false); ps = __uint_as_float(rr[0]) + __uint_as_float(rr[1]); }
    l = l * alpha + ps;
}
DI void pack_p(const f32x16& p0, const f32x16& p1, bf16x8& pa0, bf16x8& pa1, bf16x8& pa2, bf16x8& pa3) {
#define PK4(P, B_, OUT) do { unsigned a0 = cvtpk(P[B_+0], P[B_+1]), a1 = cvtpk(P[B_+2], P[B_+3]); unsigned b0 = cvtpk(P[B_+4], P[B_+5]), b1 = cvtpk(P[B_+6], P[B_+7]); \
        auto r0 = __builtin_amdgcn_permlane32_swap(a0, b0, false, false); auto r1 = __builtin_amdgcn_permlane32_swap(a1, b1, false, false); \
        u32x4 w = {r0[0], r1[0], r0[1], r1[1]}; OUT = *reinterpret_cast<bf16x8*>(&w); } while (0)
    PK4(p0, 0, pa0); PK4(p0, 8, pa1); PK4(p1, 0, pa2); PK4(p1, 8, pa3);
#undef PK4
}
DI void qkt128(f32x16& p0, f32x16& p1, const char* K_lds, int r32, int hi, const bf16x8* qr) {
    const char* kb[4];
#pragma unroll
    for (int dd = 0; dd < 4; ++dd) kb[dd] = K_lds + KSWZ(r32, (dd * 16 + hi * 8) * 2);
#pragma unroll
    for (int d0 = 0; d0 < 8; ++d0) { const char* a = kb[d0 & 3] + (d0 >> 2) * 128;
        const bf16x8 b0 = *reinterpret_cast<const bf16x8*>(a);
        const bf16x8 b1 = *reinterpret_cast<const bf16x8*>(a + 32 * 256);
        p0 = __builtin_amdgcn_mfma_f32_32x32x16_bf16(b0, qr[d0], p0, 0, 0, 0);
        p1 = __builtin_amdgcn_mfma_f32_32x32x16_bf16(b1, qr[d0], p1, 0, 0, 0); }
}
DI void qkt_rope(f32x16& p0, f32x16& p1, const char* KR_lds, int r32, int hi, const bf16x8* qr8) {
#pragma unroll
    for (int d0 = 0; d0 < 4; ++d0) { const char* a = KR_lds + r32 * 128 + (((2 * d0 + hi) ^ ((r32 >> 1) & 7)) << 4);
        const bf16x8 b0 = *reinterpret_cast<const bf16x8*>(a);
        const bf16x8 b1 = *reinterpret_cast<const bf16x8*>(a + 32 * 128);
        p0 = __builtin_amdgcn_mfma_f32_32x32x16_bf16(b0, qr8[d0], p0, 0, 0, 0);
        p1 = __builtin_amdgcn_mfma_f32_32x32x16_bf16(b1, qr8[d0], p1, 0, 0, 0); }
}
DI void pv_tile(f32x16* o, int vb0, bf16x8 pa0, bf16x8 pa1, bf16x8 pa2, bf16x8 pa3) {
#define TRRD(dst, off) asm volatile("ds_read_b64_tr_b16 %0, %1 offset:%2" : "=&v"(dst) : "v"(vb0), "i"(off) : "memory")
#define PV_D0(d0) do { s16x4 l0, l1, l2, l3, h0, h1, h2, h3; constexpr int b_ = v_rd_off(d0, 0, 0); \
        TRRD(l0, b_); TRRD(h0, b_ + 2048); TRRD(l1, b_ + 4096); TRRD(h1, b_ + 6144); TRRD(l2, b_ + 8192); TRRD(h2, b_ + 10240); TRRD(l3, b_ + 12288); TRRD(h3, b_ + 14336); \
        asm volatile("s_waitcnt lgkmcnt(0)" ::: "memory"); SBAR(); \
        o[d0] = __builtin_amdgcn_mfma_f32_32x32x16_bf16(pa0, (bf16x8){l0[0], l0[1], l0[2], l0[3], h0[0], h0[1], h0[2], h0[3]}, o[d0], 0, 0, 0); \
        o[d0] = __builtin_amdgcn_mfma_f32_32x32x16_bf16(pa1, (bf16x8){l1[0], l1[1], l1[2], l1[3], h1[0], h1[1], h1[2], h1[3]}, o[d0], 0, 0, 0); \
        o[d0] = __builtin_amdgcn_mfma_f32_32x32x16_bf16(pa2, (bf16x8){l2[0], l2[1], l2[2], l2[3], h2[0], h2[1], h2[2], h2[3]}, o[d0], 0, 0, 0); \
        o[d0] = __builtin_amdgcn_mfma_f32_32x32x16_bf16(pa3, (bf16x8){l3[0], l3[1], l3[2], l3[3], h3[0], h3[1], h3[2], h3[3]}, o[d0], 0, 0, 0); } while (0)
    PV_D0(0); PV_D0(1); PV_D0(2); PV_D0(3);
#undef PV_D0
#undef TRRD
}
DI void scale_rows(f32x16* o, float f, float* al_l, int r32, int hi) {
    if (hi == 0) al_l[r32] = f;
    asm volatile("s_waitcnt lgkmcnt(0)" ::: "memory");
#pragma unroll
    for (int r = 0; r < 16; ++r) { const float a = al_l[crow(r, hi)];
#pragma unroll
        for (int d = 0; d < 4; ++d) o[d][r] *= a; }
    asm volatile("s_waitcnt lgkmcnt(0)" ::: "memory");
}
DI void tile128(f32x16& p0, f32x16& p1, f32x16* o, float& m, float& l, float c1, const char* K_lds, int vb0, const bf16x8* qr, bool needm, int lo, int hiB, float* al_l, int r32, int hi) {
    qkt128(p0, p1, K_lds, r32, hi, qr);
    if (needm) mask_range(p0, p1, lo, hiB);
    float alpha; softmax_tile(p0, p1, m, l, c1, alpha);
    if (__any(alpha < 1.f)) scale_rows(o, alpha, al_l, r32, hi);
    bf16x8 pa0, pa1, pa2, pa3; pack_p(p0, p1, pa0, pa1, pa2, pa3); SBAR();
    pv_tile(o, vb0, pa0, pa1, pa2, pa3);
}
DI void bias_init(f32x16& p0, f32x16& p1, float b0, float step) {
#pragma unroll
    for (int r = 0; r < 16; ++r) { const float c = (float)((r & 3) + 8 * (r >> 2)); p0[r] = fmaf(step, c, b0); p1[r] = fmaf(step, c + 32.f, b0); }
}

template <int PART>
DI void nsa_unit(char* lds, int b, int g, int qt, unsigned char* ws) {
    const bf16_t* const QN = (const bf16_t*)(ws + WS_QN); const bf16_t* const KC = (const bf16_t*)(ws + WS_KC); const bf16_t* const VC = (const bf16_t*)(ws + WS_VC);
    const bf16_t* const KS = (const bf16_t*)(ws + WS_KS); const bf16_t* const VS = (const bf16_t*)(ws + WS_VS); const bf16_t* const KW = (const bf16_t*)(ws + WS_KW); const bf16_t* const VW = (const bf16_t*)(ws + WS_VW);
    const float* const GATES = (const float*)(ws + WS_GATES); float* const OTMP = (float*)(ws + WS_SLAB); float* const SSO = (float*)(ws + WS_SSO); bf16_t* const Hout = (bf16_t*)(ws + WS_H);
    int tid = threadIdx.x; asm volatile("" : "+v"(tid));
    const int wid = __builtin_amdgcn_readfirstlane(tid >> 6), lane = tid & 63, r32 = lane & 31, hi = lane >> 5;
    const int hr = wid & 3, th = wid >> 2, h = g * 4 + hr, q0 = qt * 64, tok = th * 32 + r32, t = q0 + tok;
    const size_t row = (size_t)b * SEQ + t;
    char* V_lds = lds + L_V; char* K_lds = lds + L_K; float* al_l = (float*)(lds + L_WS) + wid * 64;
    float* MAIN = (float*)(lds + L_MAIN); float* LAST = (float*)(lds + L_LAST); float* IMP = (float*)(lds + L_IMP);
    unsigned char* SELB = (unsigned char*)(lds + L_SELB); unsigned* ANY = (unsigned*)(lds + L_ANY);
    const int sr = tid >> 4, sc = (tid & 15) * 8, kws = KSWZ(sr, sc * 2), vst0 = v_st(sr, sc), vst1 = v_st(32 + sr, sc);
    const int vb0 = (int)(uintptr_t)V_lds + v_rd_base(lane);
    bf16x8 qr[8];
#pragma unroll
    for (int d0 = 0; d0 < 8; ++d0) qr[d0] = *(const bf16x8*)(QN + row * 1024 + h * 128 + d0 * 16 + hi * 8);
    const float c1 = 0.08838834764831845f * 1.4426950408889634f;
    const float cs = exp2f(-(float)(h + 1)) * 1.4426950408889634f / c1;
    bf16x8 st_k0, st_k1, st_v0, st_v1;
#define LOADKV(Kg, Vg, k0) do { st_k0 = *(const bf16x8*)((Kg) + (size_t)((k0) + sr) * 128 + sc); st_k1 = *(const bf16x8*)((Kg) + (size_t)((k0) + 32 + sr) * 128 + sc); \
                                st_v0 = *(const bf16x8*)((Vg) + (size_t)((k0) + sr) * 128 + sc); st_v1 = *(const bf16x8*)((Vg) + (size_t)((k0) + 32 + sr) * 128 + sc); } while (0)
#define WRITEKV() do { *(bf16x8*)(K_lds + kws) = st_k0; *(bf16x8*)(K_lds + kws + 32 * 256) = st_k1; *(bf16x8*)(V_lds + vst0) = st_v0; *(bf16x8*)(V_lds + vst1) = st_v1; } while (0)
    if (tid == 0) *ANY = 0u;
    const float g0 = GATES[row * 24 + h * 3 + 0], g1 = GATES[row * 24 + h * 3 + 1], g2 = GATES[row * 24 + h * 3 + 2];
    f32x16 o[4];
    const unsigned olane = (unsigned)((4 * hi) * 1024 + r32) * 4u;
    float* otw = OTMP + ((size_t)b * SEQ + q0 + th * 32) * 1024 + h * 128;
    if constexpr (PART != 1) {
    {
        const bf16_t* kb = KW + ((size_t)b * 2 + g) * SEQ * 128; const bf16_t* vb = VW + ((size_t)b * 2 + g) * SEQ * 128;
        float m = -1e30f, l = 0.f;
#pragma unroll
        for (int d = 0; d < 4; ++d) o[d] = f32x16{};
        int jt = qt >= 8 ? qt - 8 : 0;
        LOADKV(kb, vb, 64 * jt);
        for (;;) {
            __syncthreads(); WRITEKV();
            if (jt < qt) LOADKV(kb, vb, 64 * (jt + 1));
            __syncthreads();
            const int lo = t - 511 - 64 * jt - 4 * hi, hiB = t - 64 * jt - 4 * hi + 1;
            f32x16 p0, p1; bias_init(p0, p1, cs * (float)(64 * jt - q0 + 4 * hi), cs);
            tile128(p0, p1, o, m, l, c1, K_lds, vb0, qr, __any(lo > 0 || hiB < 64) != 0, lo, hiB, al_l, r32, hi);
            if (jt == qt) break;
            ++jt;
        }
        scale_rows(o, g2 / l, al_l, r32, hi);
#pragma unroll
        for (int r = 0; r < 16; ++r) { unsigned lo_ = olane; asm volatile("" : "+v"(lo_)); float* op_ = (float*)((char*)otw + (lo_ + (unsigned)(((r & 3) + 8 * (r >> 2)) * 4096)));
#pragma unroll
            for (int d0 = 0; d0 < 4; ++d0) op_[d0 * 32] = o[d0][r]; }
    }
    }
    if constexpr (PART == 0) return;
    {
        const bf16_t* kc = KC + ((size_t)b * 2 + g) * 128 * 128; const bf16_t* vc = VC + ((size_t)b * 2 + g) * 128 * 128;
        const bool two = qt >= 16;
        const int nvalid = (t >= 31) ? ((t - 31) / 16 + 1) : 0;
        float m = -1e30f, l = 0.f;
#pragma unroll
        for (int d = 0; d < 4; ++d) o[d] = f32x16{};
        float mv[2][8], lv[2][8];
        LOADKV(kc, vc, 0); __syncthreads(); WRITEKV(); if (two) LOADKV(kc, vc, 64); __syncthreads();
        {   f32x16 p0, p1; bias_init(p0, p1, cs * (16.f * (4 * hi) + 15.5f - (float)q0), cs * 16.f);
            qkt128(p0, p1, K_lds, r32, hi, qr); mask_range(p0, p1, 0, nvalid - 4 * hi);
            float alpha; softmax_tile(p0, p1, m, l, c1, alpha);
#pragma unroll
            for (int j = 0; j < 4; ++j) { mv[0][j] = (p0[4 * j] + p0[4 * j + 1]) + (p0[4 * j + 2] + p0[4 * j + 3]); lv[0][j] = p0[4 * j + 3];
                                          mv[0][4 + j] = (p1[4 * j] + p1[4 * j + 1]) + (p1[4 * j + 2] + p1[4 * j + 3]); lv[0][4 + j] = p1[4 * j + 3]; }
            bf16x8 pa0, pa1, pa2, pa3; pack_p(p0, p1, pa0, pa1, pa2, pa3); SBAR(); pv_tile(o, vb0, pa0, pa1, pa2, pa3); }
        if (two) {
            __syncthreads(); WRITEKV(); __syncthreads();
            f32x16 p0, p1; bias_init(p0, p1, cs * (16.f * (64 + 4 * hi) + 15.5f - (float)q0), cs * 16.f);
            qkt128(p0, p1, K_lds, r32, hi, qr); mask_range(p0, p1, 0, nvalid - 64 - 4 * hi);
            float alpha; softmax_tile(p0, p1, m, l, c1, alpha);
            if (__any(alpha < 1.f)) scale_rows(o, alpha, al_l, r32, hi);
#pragma unroll
            for (int j = 0; j < 8; ++j) { mv[0][j] *= alpha; lv[0][j] *= alpha; }
#pragma unroll
            for (int j = 0; j < 4; ++j) { mv[1][j] = (p0[4 * j] + p0[4 * j + 1]) + (p0[4 * j + 2] + p0[4 * j + 3]); lv[1][j] = p0[4 * j + 3];
                                          mv[1][4 + j] = (p1[4 * j] + p1[4 * j + 1]) + (p1[4 * j + 2] + p1[4 * j + 3]); lv[1][4 + j] = p1[4 * j + 3]; }
            bf16x8 pa0, pa1, pa2, pa3; pack_p(p0, p1, pa0, pa1, pa2, pa3); SBAR(); pv_tile(o, vb0, pa0, pa1, pa2, pa3);
        } else {
#pragma unroll
            for (int j = 0; j < 8; ++j) { mv[1][j] = 0.f; lv[1][j] = 0.f; }
        }
        LOADKV(KS + ((size_t)b * 2 + g) * SEQ * 128, VS + ((size_t)b * 2 + g) * SEQ * 128, 0);
        const float inv = l > 0.f ? 1.0f / l : 0.f;
        const int R = hr * 64 + tok;
#pragma unroll
        for (int ti = 0; ti < 2; ++ti)
#pragma unroll
            for (int hf = 0; hf < 2; ++hf)
#pragma unroll
                for (int j = 0; j < 4; ++j) { const int s = 2 * j + hi + 8 * hf + 16 * ti; MAIN[R * 33 + s] = mv[ti][4 * hf + j] * inv; LAST[R * 33 + s] = lv[ti][4 * hf + j] * inv; }
        scale_rows(o, g0 * inv, al_l, r32, hi);
        {   float tmp[16][4];
#pragma unroll
            for (int r = 0; r < 16; ++r) { unsigned lo_ = olane; asm volatile("" : "+v"(lo_)); const float* op_ = (const float*)((const char*)otw + (lo_ + (unsigned)(((r & 3) + 8 * (r >> 2)) * 4096)));
#pragma unroll
                for (int d0 = 0; d0 < 4; ++d0) tmp[r][d0] = op_[d0 * 32]; }
#pragma unroll
            for (int r = 0; r < 16; ++r) { unsigned lo_ = olane; asm volatile("" : "+v"(lo_)); float* op_ = (float*)((char*)otw + (lo_ + (unsigned)(((r & 3) + 8 * (r >> 2)) * 4096)));
#pragma unroll
                for (int d0 = 0; d0 < 4; ++d0) op_[d0 * 32] = tmp[r][d0] + o[d0][r]; } }
    }
    __syncthreads();
    {
        const int tok2 = tid & 63, sg = tid >> 6, t2 = q0 + tok2;
#pragma unroll
        for (int i = 0; i < 4; ++i) { const int s = sg * 4 + i; float imp = 0.f;
#pragma unroll
            for (int rr = 0; rr < 4; ++rr) { imp += MAIN[(rr * 64 + tok2) * 33 + s]; if (s > 0) imp += LAST[(rr * 64 + tok2) * 33 + s - 1]; }
            const bool forced = (s == 0) || (s == qt), future = (64 * s > t2);
            IMP[tok2 * 33 + s] = future ? -1e30f : (forced ? 1e4f : imp); }
        __syncthreads();
        unsigned nib = 0u;
#pragma unroll
        for (int i = 0; i < 4; ++i) { const int s = sg * 4 + i; const float v = IMP[tok2 * 33 + s]; int rank = 0;
            for (int s2 = 0; s2 < 32; ++s2) { const float ov = IMP[tok2 * 33 + s2]; rank += (ov > v || (ov == v && s2 < s)) ? 1 : 0; }
            nib |= (rank < 8 ? 1u : 0u) << i; }
        SELB[tok2 * 8 + sg] = (unsigned char)nib;
        __syncthreads();
    }
    unsigned mymask = 0u;
    { const u32x2 wv = *(const u32x2*)(SELB + tok * 8);
#pragma unroll
      for (int k = 0; k < 4; ++k) { mymask |= ((wv.x >> (8 * k)) & 0xfu) << (4 * k); mymask |= ((wv.y >> (8 * k)) & 0xfu) << (16 + 4 * k); } }
    if (hr == 0 && hi == 0) atomicOr(ANY, mymask);
    __syncthreads();
    {
        const bf16_t* kb = KS + ((size_t)b * 2 + g) * SEQ * 128; const bf16_t* vb = VS + ((size_t)b * 2 + g) * SEQ * 128;
        unsigned rem = *ANY & (qt == 31 ? 0xffffffffu : ((1u << (qt + 1)) - 1u));
        rem = __builtin_amdgcn_readfirstlane(rem);
        float m = -1e30f, l = 0.f;
#pragma unroll
        for (int d = 0; d < 4; ++d) o[d] = f32x16{};
        int s = 0; rem &= rem - 1u;
        for (;;) {
            __syncthreads(); WRITEKV();
            const int sn = rem ? __builtin_ctz(rem) : -1;
            if (sn >= 0) { rem &= rem - 1u; LOADKV(kb, vb, 64 * sn); }
            __syncthreads();
            const bool sel = (mymask >> s) & 1u;
            const int hiB = sel ? (s == qt ? tok - 4 * hi + 1 : 64) : 0;
            if (__any(hiB > 0)) {
            f32x16 p0, p1; bias_init(p0, p1, cs * (float)(64 * s - q0 + 4 * hi), cs);
            tile128(p0, p1, o, m, l, c1, K_lds, vb0, qr, __any(hiB < 64) != 0, 0, hiB, al_l, r32, hi); }
            if (sn < 0) break;
            s = sn;
        }
        scale_rows(o, g1 / l, al_l, r32, hi);
        {   float tmp[16][4];
#pragma unroll
            for (int r = 0; r < 16; ++r) { unsigned lo_ = olane; asm volatile("" : "+v"(lo_)); const float* op_ = (const float*)((const char*)otw + (lo_ + (unsigned)(((r & 3) + 8 * (r >> 2)) * 4096)));
#pragma unroll
                for (int d0 = 0; d0 < 4; ++d0) tmp[r][d0] = op_[d0 * 32]; }
#pragma unroll
            for (int r = 0; r < 16; ++r)
#pragma unroll
                for (int d0 = 0; d0 < 4; ++d0) o[d0][r] += tmp[r][d0]; }
    }
    {
        {   float* sp = SSO + ((size_t)b * SEQ + q0 + th * 32) * 16 + h;
#pragma unroll
            for (int r = 0; r < 16; ++r) { float q = (o[0][r] * o[0][r] + o[1][r] * o[1][r]) + (o[2][r] * o[2][r] + o[3][r] * o[3][r]);
                q += __shfl_xor(q, 1); q += __shfl_xor(q, 2); q += __shfl_xor(q, 4); q += __shfl_xor(q, 8); q += __shfl_xor(q, 16);
                if (r32 == 0) sp[(size_t)crow(r, hi) * 16] = q; } }
        bf16_t* Ow = Hout + ((size_t)b * SEQ + q0 + th * 32) * DM + h * 128;
#pragma unroll
        for (int r = 0; r < 16; ++r) { unsigned lo_ = (unsigned)((4 * hi) * DM + r32) * 2u; asm volatile("" : "+v"(lo_)); char* op_ = (char*)Ow + (lo_ + (unsigned)(((r & 3) + 8 * (r >> 2)) * DM * 2));
#pragma unroll
            for (int d0 = 0; d0 < 4; ++d0) { const float v = o[d0][r]; const float vn = __shfl_xor(v, 1);
                if ((r32 & 1) == 0) *(unsigned*)(op_ + d0 * 64) = cvtpk(v, vn); } }
    }
    __syncthreads();
#undef LOADKV
#undef WRITEKV
}

DI void mla_unit(char* lds, int b, int h, int qb, const bf16_t* QM, const bf16_t* KM, const bf16_t* VM, const float* qgain, const float* ropet, float* SSO, bf16_t* Hout) {
    int tid = threadIdx.x; asm volatile("" : "+v"(tid));
    const int wid = __builtin_amdgcn_readfirstlane(tid >> 6), lane = tid & 63, r32 = lane & 31, hi = lane >> 5;
    const int q0 = qb * 256, w0 = q0 + wid * 32, t = w0 + r32;
    const size_t row = (size_t)b * SEQ + t;
    char* V_lds = lds + L_V; char* K_lds = lds + L_K; char* KR_lds = lds + L_KR; float* al_l = (float*)(lds + L_WS) + wid * 64;
    const int sr = tid >> 4, sc = (tid & 15) * 8, vst0 = v_st(sr, sc), vst1 = v_st(32 + sr, sc);
    const int kr_ = tid >> 3, c8 = tid & 7, kws = KSWZ(kr_, c8 * 16), krs = kr_ * 128 + ((c8 ^ ((kr_ >> 1) & 7)) << 4);
    const int vb0 = (int)(uintptr_t)V_lds + v_rd_base(lane);
    bf16x8 qr[12];
#pragma unroll
    for (int d0 = 0; d0 < 12; ++d0) qr[d0] = *(const bf16x8*)(QM + row * 1536 + h * 192 + d0 * 16 + hi * 8);
    {
        float ssq = 0.f;
#pragma unroll
        for (int d0 = 0; d0 < 12; ++d0)
#pragma unroll
            for (int j = 0; j < 8; ++j) { const float v = bf2f((bf16_t)qr[d0][j]); ssq = fmaf(v, v, ssq); }
        { auto rr = __builtin_amdgcn_permlane32_swap(__float_as_uint(ssq), __float_as_uint(ssq), false, false); ssq = __uint_as_float(rr[0]) + __uint_as_float(rr[1]); }
        const float rq = 1.0f / sqrtf(ssq * (1.0f / 192.0f) + EPS);
#pragma unroll
        for (int d0 = 0; d0 < 8; ++d0) { const f32x4 ga = *(const f32x4*)(qgain + d0 * 16 + hi * 8), gb = *(const f32x4*)(qgain + d0 * 16 + hi * 8 + 4);
            u32x4 w; w.x = cvtpk(bf2f((bf16_t)qr[d0][0]) * rq * ga[0], bf2f((bf16_t)qr[d0][1]) * rq * ga[1]); w.y = cvtpk(bf2f((bf16_t)qr[d0][2]) * rq * ga[2], bf2f((bf16_t)qr[d0][3]) * rq * ga[3]);
            w.z = cvtpk(bf2f((bf16_t)qr[d0][4]) * rq * gb[0], bf2f((bf16_t)qr[d0][5]) * rq * gb[1]); w.w = cvtpk(bf2f((bf16_t)qr[d0][6]) * rq * gb[2], bf2f((bf16_t)qr[d0][7]) * rq * gb[3]);
            qr[d0] = *reinterpret_cast<bf16x8*>(&w); }
#pragma unroll
        for (int dd = 0; dd < 2; ++dd) {
            const int i0 = 16 * dd + 8 * hi; const float* rp = ropet + ((size_t)t * 32 + i0) * 2; float o1[8], o2[8];
#pragma unroll
            for (int e = 0; e < 2; ++e) { const f32x4 g1 = *(const f32x4*)(qgain + 128 + i0 + 4 * e), g2 = *(const f32x4*)(qgain + 160 + i0 + 4 * e), cs0 = *(const f32x4*)(rp + 8 * e), cs1 = *(const f32x4*)(rp + 8 * e + 4);
#pragma unroll
                for (int j = 0; j < 4; ++j) { const float a = bf2f((bf16_t)qr[8 + dd][4 * e + j]) * rq * g1[j], c = bf2f((bf16_t)qr[10 + dd][4 * e + j]) * rq * g2[j];
                    const float co = j < 2 ? cs0[2 * j] : cs1[2 * (j - 2)], si = j < 2 ? cs0[2 * j + 1] : cs1[2 * (j - 2) + 1];
                    o1[4 * e + j] = a * co - c * si; o2[4 * e + j] = c * co + a * si; } }
            u32x4 w1, w2; w1.x = cvtpk(o1[0], o1[1]); w1.y = cvtpk(o1[2], o1[3]); w1.z = cvtpk(o1[4], o1[5]); w1.w = cvtpk(o1[6], o1[7]);
            w2.x = cvtpk(o2[0], o2[1]); w2.y = cvtpk(o2[2], o2[3]); w2.z = cvtpk(o2[4], o2[5]); w2.w = cvtpk(o2[6], o2[7]);
            qr[8 + dd] = *reinterpret_cast<bf16x8*>(&w1); qr[10 + dd] = *reinterpret_cast<bf16x8*>(&w2); }
    }
    const float c1 = 0.07216878364870322f * 1.4426950408889634f;
    const bf16_t* kb = KM + ((size_t)b * 8 + h) * SEQ * 192; const bf16_t* vb = VM + ((size_t)b * 8 + h) * SEQ * 128;
    bf16x8 st_k0, st_k1, st_k2, st_v0, st_v1;
#define LOADKV(k0) do { const bf16_t* kp_ = kb + (size_t)((k0) + kr_) * 192 + c8 * 8; st_k0 = *(const bf16x8*)kp_; st_k1 = *(const bf16x8*)(kp_ + 64); st_k2 = *(const bf16x8*)(kp_ + 128); \
                        st_v0 = *(const bf16x8*)(vb + (size_t)((k0) + sr) * 128 + sc); st_v1 = *(const bf16x8*)(vb + (size_t)((k0) + 32 + sr) * 128 + sc); } while (0)
#define WRITEKV() do { *(bf16x8*)(K_lds + kws) = st_k0; *(bf16x8*)(K_lds + kws + 128) = st_k1; *(bf16x8*)(KR_lds + krs) = st_k2; *(bf16x8*)(V_lds + vst0) = st_v0; *(bf16x8*)(V_lds + vst1) = st_v1; } while (0)
    float m = -1e30f, l = 0.f; f32x16 o[4];
#pragma unroll
    for (int d = 0; d < 4; ++d) o[d] = f32x16{};
    const int ntile = 4 * qb + 4;
    LOADKV(0);
    for (int jt = 0; jt < ntile; ++jt) {
        __syncthreads(); WRITEKV();
        if (jt + 1 < ntile) LOADKV(64 * (jt + 1));
        __syncthreads();
        if (64 * jt <= w0 + 31) {
            f32x16 p0 = f32x16{}, p1 = f32x16{};
            qkt128(p0, p1, K_lds, r32, hi, qr); qkt_rope(p0, p1, KR_lds, r32, hi, qr + 8);
            if (64 * jt + 63 > w0) mask_range(p0, p1, -4096, t - 64 * jt - 4 * hi + 1);
            float alpha; softmax_tile(p0, p1, m, l, c1, alpha);
            if (__any(alpha < 1.f)) scale_rows(o, alpha, al_l, r32, hi);
            bf16x8 pa0, pa1, pa2, pa3; pack_p(p0, p1, pa0, pa1, pa2, pa3); SBAR();
            pv_tile(o, vb0, pa0, pa1, pa2, pa3);
        }
    }
    scale_rows(o, 1.0f / l, al_l, r32, hi);
    {
        {   float* sp = SSO + ((size_t)b * SEQ + w0) * 16 + 8 + h;
#pragma unroll
            for (int r = 0; r < 16; ++r) { float q = (o[0][r] * o[0][r] + o[1][r] * o[1][r]) + (o[2][r] * o[2][r] + o[3][r] * o[3][r]);
                q += __shfl_xor(q, 1); q += __shfl_xor(q, 2); q += __shfl_xor(q, 4); q += __shfl_xor(q, 8); q += __shfl_xor(q, 16);
                if (r32 == 0) sp[(size_t)crow(r, hi) * 16] = q; } }
        bf16_t* Ow = Hout + ((size_t)b * SEQ + w0) * DM + 1024 + h * 128;
#pragma unroll
        for (int r = 0; r < 16; ++r) { unsigned lo_ = (unsigned)((4 * hi) * DM + r32) * 2u; asm volatile("" : "+v"(lo_)); char* op_ = (char*)Ow + (lo_ + (unsigned)(((r & 3) + 8 * (r >> 2)) * DM * 2));
#pragma unroll
            for (int d0 = 0; d0 < 4; ++d0) { const float v = o[d0][r]; const float vn = __shfl_xor(v, 1);
                if ((r32 & 1) == 0) *(unsigned*)(op_ + d0 * 64) = cvtpk(v, vn); } }
    }
    __syncthreads();
#undef LOADKV
#undef WRITEKV
}
#undef KSWZ
#undef SBAR
}

#define XB_TMO      128
#define XB_XCNT(j)  (256  + 64 * (j))
#define XB_XSUB(j)  (1280 + 64 * (j))
#define XB_XGEN(j)  (2304 + 64 * (j))
#define XB_TOP      3328
#define XB_TOPGEN   3392
#define XB2_XSUB(j) (3456 + 64 * (j))
#define XB2_TOP     4480
#define XB2_DONE    4544
#define XB_SET(i)   (3456 + 1152 * ((i) - 2))
#define XCD_BAR_WORDS 6912
#define XB_XCCTAB   6912
#define XB_SPIN_CAP (1u << 18)
#define LAS __attribute__((address_space(3)))
DI unsigned xb_ld(unsigned* p)              { return __hip_atomic_load(p, __ATOMIC_RELAXED, __HIP_MEMORY_SCOPE_AGENT); }
DI unsigned xb_add(unsigned* p, unsigned v) { return __hip_atomic_fetch_add(p, v, __ATOMIC_RELAXED, __HIP_MEMORY_SCOPE_AGENT); }
DI unsigned xb_xcc_id() { return (unsigned)__builtin_amdgcn_s_getreg((3 << 11) | 20) & 0xFu; }
#define XB_SPIN(cond, bar) do { unsigned _sp = 0; while (cond) { __builtin_amdgcn_s_sleep(1); \
    if ((++_sp & 255u) == 0u) { if (xb_ld(&(bar)[XB_TMO])) break; if (_sp > XB_SPIN_CAP) { atomicAdd(&(bar)[XB_TMO], 1u); break; } } } } while (0)
struct XcdBarrier { unsigned* bar; unsigned x; volatile LAS unsigned* st; };
DI XcdBarrier xcd_barrier_post(unsigned* bar, volatile LAS unsigned* st) {
    XcdBarrier b; b.bar = bar; b.x = xb_xcc_id(); b.st = st;
    if (threadIdx.x == 0) (void)xb_add(&bar[XB_XCNT(b.x)], 1u);
    return b;
}
DI void xcd_barrier_complete(unsigned* bar, unsigned x, unsigned& nloc, unsigned& nx) {
    const unsigned G = gridDim.x * gridDim.y * gridDim.z;
    unsigned sum, cnt, mine, sp = 0u;
    for (;;) {
        sum = 0u; cnt = 0u; mine = 0u;
#pragma unroll
        for (unsigned j = 0; j < 16; ++j) { const unsigned c = xb_ld(&bar[XB_XCNT(j)]); sum += c; cnt += (c > 0u) ? 1u : 0u; mine = (j == x) ? c : mine; }
        if (sum == G) break;
        __builtin_amdgcn_s_sleep(1);
        if ((++sp & 255u) == 0u) { if (xb_ld(&bar[XB_TMO])) break; if (sp > XB_SPIN_CAP) { atomicAdd(&bar[XB_TMO], 1u); break; } }
    }
    nloc = mine > 0u ? mine : 1u; nx = cnt > 0u ? cnt : 1u;
}
DI void xcd_barrier(const XcdBarrier& b) {
    asm volatile("s_waitcnt vmcnt(0)" ::: "memory");
    __syncthreads();
    if (threadIdx.x == 0) {
        unsigned* bar = b.bar;
        __builtin_amdgcn_s_waitcnt(0);
        unsigned nloc = b.st[0], nx = b.st[1];
        if (nloc == 0u) { xcd_barrier_complete(bar, b.x, nloc, nx); b.st[0] = nloc; b.st[1] = nx; }
        const unsigned old = xb_add(&bar[XB_XSUB(b.x)], 1u);
        const unsigned gen = old / nloc;
        if (old + 1u == (gen + 1u) * nloc) {
            __builtin_amdgcn_fence(__ATOMIC_RELEASE, "agent");
            asm volatile("s_waitcnt vmcnt(0)" ::: "memory");
            const unsigned og = xb_add(&bar[XB_TOP], 1u);
            const unsigned tg = og / nx;
            if (og + 1u == (tg + 1u) * nx) xb_add(&bar[XB_TOPGEN], 1u);
            else XB_SPIN(xb_ld(&bar[XB_TOPGEN]) == tg, bar);
            __builtin_amdgcn_fence(__ATOMIC_ACQUIRE, "agent");
            xb_add(&bar[XB_XGEN(b.x)], 1u);
            asm volatile("s_waitcnt vmcnt(0)" ::: "memory");
        } else {
            XB_SPIN(xb_ld(&bar[XB_XGEN(b.x)]) == gen, bar);
            __builtin_amdgcn_fence(__ATOMIC_ACQUIRE, "agent");
            asm volatile("s_waitcnt vmcnt(0)" ::: "memory");
        }
    }
    __syncthreads();
}

DI void xcd_barrier_local(const XcdBarrier& b) {
    asm volatile("s_waitcnt vmcnt(0)" ::: "memory");
    __syncthreads();
    if (threadIdx.x == 0) {
        unsigned* bar = b.bar;
        __builtin_amdgcn_s_waitcnt(0);
        unsigned nloc = b.st[0], nx = b.st[1];
        if (nloc == 0u) { xcd_barrier_complete(bar, b.x, nloc, nx); b.st[0] = nloc; b.st[1] = nx; }
        const unsigned old = xb_add(&bar[XB_XSUB(b.x)], 1u);
        const unsigned gen = old / nloc;
        if (old + 1u == (gen + 1u) * nloc) xb_add(&bar[XB_XGEN(b.x)], 1u);
        else XB_SPIN(xb_ld(&bar[XB_XGEN(b.x)]) == gen, bar);
        __builtin_amdgcn_fence(__ATOMIC_ACQUIRE, "agent");
        asm volatile("s_waitcnt vmcnt(0)" ::: "memory");
    }
    __syncthreads();
}
DI bool xcd_groups_local(unsigned* barw, int G) {
    int ok = (G == 256) ? 1 : 0;
    if (ok && threadIdx.x < 256) ok = (xb_ld(&barw[XB_XCCTAB + threadIdx.x]) == xb_ld(&barw[XB_XCCTAB + (threadIdx.x & 7)])) ? 1 : 0;
    return __syncthreads_and(ok) != 0;
}
DI void xcd_arrive_s(const XcdBarrier& b, int base) {
    asm volatile("s_waitcnt vmcnt(0)" ::: "memory");
    __syncthreads();
    if (threadIdx.x == 0) {
        unsigned* bar = b.bar;
        __builtin_amdgcn_s_waitcnt(0);
        unsigned nloc = b.st[0], nx = b.st[1];
        if (nloc == 0u) { xcd_barrier_complete(bar, b.x, nloc, nx); b.st[0] = nloc; b.st[1] = nx; }
        const unsigned old = xb_add(&bar[base + 64 * b.x], 1u);
        if (old + 1u == nloc) {
            __builtin_amdgcn_fence(__ATOMIC_RELEASE, "agent");
            asm volatile("s_waitcnt vmcnt(0)" ::: "memory");
            const unsigned og = xb_add(&bar[base + 1024], 1u);
            if (og + 1u == nx) xb_add(&bar[base + 1088], 1u);
            asm volatile("s_waitcnt vmcnt(0)" ::: "memory");
        }
    }
}
DI void xcd_wait_flag(unsigned* bar, int base, bool acquire) {
    if (threadIdx.x == 0) {
        XB_SPIN(xb_ld(&bar[base + 1088]) == 0u, bar);
        if (acquire) { __builtin_amdgcn_fence(__ATOMIC_ACQUIRE, "agent"); asm volatile("s_waitcnt vmcnt(0)" ::: "memory"); }
    }
    __syncthreads();
}
DI void xcd_arrive2(const XcdBarrier& b) { xcd_arrive_s(b, XB_SET(2)); }
DI void xcd_wait_s(const XcdBarrier& b, int base, bool acquire) { xcd_wait_flag(b.bar, base, acquire); }
static_assert(XB_SET(2) == 3456, "nsa_unit waits on set 2");

struct P6Order {
    const bf16_t *cq, *wuq, *ckv, *wukv, *kcmp, *vcmp, *w1k, *w1v; int G, c;
    DI void four(int f, pg8::Unit& u) const {
        if (f < 256) { const int pm = f >> 3, pn = f & 7; u.A = (const char*)(ckv + (size_t)pm * 256 * 256); u.B = (const char*)(wukv + (size_t)pn * 256 * 256);
            u.pm = pm; u.pn = pn; u.aux = 0; u.type = 1; }
        else { const int e = f - 256, pm = e & 1, sp = (e >> 1) & 15, g = (e >> 5) & 1, kv = e >> 6;
            u.A = (const char*)((kv ? vcmp : kcmp) + (size_t)g * NB * SEQ * 128 + (size_t)pm * 256 * 2048 + sp * 256); u.B = (const char*)((kv ? w1v : w1k) + sp * 256);
            u.pm = pm; u.pn = 0; u.aux = (kv * 2 + g) * NSPLIT + sp; u.type = 2; }
    }
    DI void qunit(int j, pg8::Unit& u) const { const int pm = j / 6, pn = j - 6 * pm; u.A = (const char*)(cq + (size_t)pm * 256 * 384); u.B = (const char*)(wuq + (size_t)pn * 256 * 384);
        u.pm = pm; u.pn = pn; u.aux = 0; u.type = 0; }
    DI bool next(int i, pg8::Unit& u) const {
        if (G == 256) {
            if (c < 192) { if (i == 0) { qunit(c, u); return true; } if (i == 1) { four(64 + c, u); return true; } return false; }
            if (i > 2) return false; four((i == 0 ? 0 : (i == 1 ? 256 : 320)) + (c - 192), u); return true;
        }
        const int L = i * G + c; if (L >= 576) return false;
        if (L < 192) qunit(L, u); else four(L - 192, u); return true;
    }
};
struct CmpOrder {
    const bf16_t *kcmp, *vcmp, *w1k, *w1v; int G, c;
    DI bool next(int i, pg8::Unit& u) const {
        const int L = i * G + c; if (L >= 8 * NSPLIT) return false;
        const int pm = L & 1, sp = (L >> 1) % NSPLIT, g = (L / (2 * NSPLIT)) & 1, kv = L / (4 * NSPLIT);
        u.A = (const char*)((kv ? vcmp : kcmp) + (size_t)g * NB * SEQ * 128 + (size_t)pm * 256 * 2048 + sp * (4096 / NSPLIT));
        u.B = (const char*)((kv ? w1v : w1k) + sp * (4096 / NSPLIT)); u.pm = pm; u.pn = 0; u.aux = (kv * 2 + g) * NSPLIT + sp; return true;
    }
};
struct CmpFinalize {
    unsigned char* ws; const float* w2k; const float* w2v; const float* kgain; char* lds;
    DI void operator()() const {
        const int G = (int)gridDim.x, bid = (int)blockIdx.x;
        const bool fast = (G == 256) && (((volatile LAS unsigned*)((PG8_LAS unsigned char*)lds + (LDS_BYTES - 64)))[2] != 0u);
        int tid = threadIdx.x; asm volatile("" : "+v"(tid)); const int lane = tid & 63, wid = tid >> 6;
        const XcdBarrier xb{(unsigned*)(ws + WS_BAR), xb_xcc_id(), (volatile LAS unsigned*)((PG8_LAS unsigned char*)lds + (LDS_BYTES - 64))};
        if (fast) xcd_wait_flag(xb.bar, XB_SET(2), true);
        float* hid = (float*)(lds + att::L_MAIN) + wid * 256;
        const int ngw = G * 8, nrows = 2 * NB * 2 * 128;
        for (int it = bid * 8 + wid; it < nrows; it += ngw) {
            int n, g, b, kv;
            if (fast) { const int v = bid & 7, j = (bid >> 3) * 8 + wid; b = v >> 1; g = v & 1; kv = j >> 7; n = j & 127; }
            else { n = it & 127; g = (it >> 7) & 1; b = (it >> 8) & 3; kv = it >> 10; }
            bf16_t* dst = (bf16_t*)(ws + (kv ? WS_VC : WS_KC)) + (((size_t)b * 2 + g) * 128 + n) * 128;
            if (n == 127) { *(unsigned*)(dst + 2 * lane) = 0u; continue; }
            const float* w2 = kv ? w2v : w2k;
#pragma unroll
            for (int i = 0; i < 4; ++i) {
                const int k = lane + 64 * i; float a = 0.f;
                for (int sp = 0; sp < NSPLIT; ++sp) a += ((const float*)(ws + WS_CSLAB))[((size_t)((kv * 2 + g) * NSPLIT + sp) * 512 + b * 128 + n) * 256 + k];
                a += ((const float*)(ws + WS_BIASP))[2 * NBIASP * 256 + kv * 256 + k];
                const float t3 = 0.7978845608028654f * (a + 0.044715f * a * a * a);
                hid[k] = 0.5f * a * (1.0f + tanhf(t3));
            }
            __builtin_amdgcn_s_waitcnt(0xc07f); asm volatile("" ::: "memory");
            float o0 = 0.f, o1 = 0.f;
            {   float p0[4] = {0.f, 0.f, 0.f, 0.f}, p1[4] = {0.f, 0.f, 0.f, 0.f};
                for (int k0 = 0; k0 < 256; k0 += 16) {
                    f32x2 w[16];
#pragma unroll
                    for (int u = 0; u < 16; ++u) w[u] = *(const f32x2*)(w2 + (size_t)(k0 + u) * 128 + 2 * lane);
#pragma unroll
                    for (int u = 0; u < 16; ++u) { const float hk = hid[k0 + u]; p0[u & 3] = fmaf(hk, w[u].x, p0[u & 3]); p1[u & 3] = fmaf(hk, w[u].y, p1[u & 3]); }
                }
                o0 = (p0[0] + p0[1]) + (p0[2] + p0[3]); o1 = (p1[0] + p1[1]) + (p1[2] + p1[3]); }
            if (kv == 0) { const float rr = 1.0f / sqrtf(wave_sum(o0 * o0 + o1 * o1) * (1.0f / 128.0f) + EPS); o0 *= rr * kgain[2 * lane]; o1 *= rr * kgain[2 * lane + 1]; }
            *(unsigned*)(dst + 2 * lane) = pk2(o0, o1);
            __builtin_amdgcn_s_waitcnt(0xc07f); asm volatile("" ::: "memory");
        }
        if (fast) xcd_barrier_local(xb); else xcd_barrier(xb);
    }
};

__global__ void __launch_bounds__(NTHREADS, 2) mega(Args args) {
    extern __shared__ __attribute__((aligned(16))) char lds[];
    const int tid = threadIdx.x, lane = tid & 63, wid = tid >> 6;
    const int G = gridDim.x, bid = blockIdx.x;
    const int gw = bid * 8 + wid, ngw = G * 8;
    unsigned char* ws = args.ws;
    const float* x = args.in[0];
    float* out = args.out;
#define WGU1 ((bf16_t*)(ws + WS_WGU1))
#define WD1 ((bf16_t*)(ws + WS_WD1))
#define WGU2 ((bf16_t*)(ws + WS_WGU2))
#define WD2 ((bf16_t*)(ws + WS_WD2))
#define WIN ((bf16_t*)(ws + WS_WIN))
#define WOUT ((bf16_t*)(ws + WS_WOUT))
#define WUQ ((bf16_t*)(ws + WS_WUQ))
#define WUKV ((bf16_t*)(ws + WS_WUKV))
#define WC1K ((bf16_t*)(ws + WS_WC1K))
#define WC1V ((bf16_t*)(ws + WS_WC1V))
#define H ((bf16_t*)(ws + WS_H))
#define ACT ((bf16_t*)(ws + WS_ACT))
#define PROJ ((bf16_t*)(ws + WS_PROJ))
#define QM ((bf16_t*)(ws + WS_QM))
#define KNRAW ((bf16_t*)(ws + WS_KNRAW))
#define KM ((bf16_t*)(ws + WS_KM))
#define VM ((bf16_t*)(ws + WS_VM))
#define QN ((bf16_t*)(ws + WS_QN))
#define KS ((bf16_t*)(ws + WS_KS))
#define VS ((bf16_t*)(ws + WS_VS))
#define KW ((bf16_t*)(ws + WS_KW))
#define VW ((bf16_t*)(ws + WS_VW))
#define KCMP ((bf16_t*)(ws + WS_KCMP))
#define VCMP ((bf16_t*)(ws + WS_VCMP))
#define CQ ((bf16_t*)(ws + WS_CQ))
#define CKV ((bf16_t*)(ws + WS_CKV))
#define KROPE ((float*)(ws + WS_KROPE))
#define GATES ((float*)(ws + WS_GATES))
#define KC ((bf16_t*)(ws + WS_KC))
#define VC ((bf16_t*)(ws + WS_VC))
#define SS ((float*)(ws + WS_SS))
#define SSO ((float*)(ws + WS_SSO))
#define H2 ((bf16_t*)(ws + WS_H2))
#define H2F8 (ws + WS_ACT + 44 * MiB)
#define BIASP ((float*)(ws + WS_BIASP))
#define ROPE ((float*)(ws + WS_ROPE))
#define SLAB ((float*)(ws + WS_SLAB))
#define X1B ((bf16_t*)out)
#define BIAS1 (BIASP + 2 * NBIASP * 256)
    PG8_LAS unsigned char* ldsp = (PG8_LAS unsigned char*)lds;
    unsigned* barw = (unsigned*)(ws + WS_BAR);
    volatile LAS unsigned* xst = (volatile LAS unsigned*)(ldsp + (LDS_BYTES - 64));
    if (tid < 3) xst[tid] = 0u;
    if (tid == 0) barw[XB_XCCTAB + (bid & 255)] = xb_xcc_id();
#if !MK_NO_CG
    if (bid == 0) for (int i = tid; i < XCD_BAR_WORDS; i += NTHREADS) barw[i] = 0u;
#endif
#define xbar (XcdBarrier{(unsigned*)(args.ws + WS_BAR), xb_xcc_id(), (volatile LAS unsigned*)(ldsp + (LDS_BYTES - 64))})
#define local_ok (xst[2] != 0u)
    __syncthreads();
#if MK_NO_CG
    (void)xcd_barrier_post(barw, xst);
#endif
    const int lo = args.ph_lo, hi = args.ph_hi;
#ifndef PHASE_MASK
#define PHASE_MASK 0xffffffffu
#endif
#ifndef REPEAT_MASK
#define REPEAT_MASK 0u
#endif
#define IN(k) (((PHASE_MASK >> (k)) & 1u) && lo <= (k) && (k) < hi)
#if MK_ONE_LAUNCH
#if MK_NO_CG
#define SEAM(k) do { if (IN(k) && IN((k) + 1)) { xcd_barrier(xbar); if ((k) == 0) { const bool lk_ = xcd_groups_local(barw, G); if (threadIdx.x == 0) xst[2] = lk_ ? 1u : 0u; __syncthreads(); } } } while (0)
#else
#define SEAM(k) do { if (IN(k) && IN((k) + 1)) { if ((k) == 0) { cg::this_grid().sync(); (void)xcd_barrier_post(barw, xst); { const bool lk_ = xcd_groups_local(barw, G); if (threadIdx.x == 0) xst[2] = lk_ ? 1u : 0u; __syncthreads(); } } else xcd_barrier(xbar); } } while (0)
#endif
#define SEAML(k, k2) do { if (IN(k) && IN(k2)) { if (local_ok) xcd_barrier_local(xbar); else xcd_barrier(xbar); } } while (0)
#define NREP(k) (1 + (int)((REPEAT_MASK >> (k)) & 1u))
#define PH(k) for (int rep_ = 0; rep_ < NREP(k); ((rep_ + 1 < NREP(k)) ? cg::this_grid().sync() : (void)0, ++rep_)) if (IN(k))
#else
#define PH(k) if (IN(k))
#define SEAM(k) do { } while (0)
#endif

    PH(0) { size_t wsz_ = 0; asm volatile("" : "+s"(wsz_)); unsigned char* ws = args.ws + wsz_;     int tid = threadIdx.x; asm volatile("" : "+v"(tid)); const int lane = tid & 63, wid = tid >> 6, gw = bid * 8 + wid; (void)lane; (void)gw;
        float* scr = (float*)lds + wid * (64 * 33);
        transpose_all<MapGU, I8_W_SCALE, true>(args.in[2], DM, DFF, WGU1, MapGU{0}, nullptr, scr, gw, ngw, lane);
        transpose_all<MapGU, I8_W_SCALE, true>(args.in[3], DM, DFF, WGU1, MapGU{1}, nullptr, scr, gw, ngw, lane);
        transpose_all<MapGU, I8_W_SCALE, true>(args.in[25], DM, DFF, WGU2, MapGU{0}, args.in[24], scr, gw, ngw, lane, nullptr, 1 << 30, WGU2_GC, 1 << 30);
        transpose_all<MapGU, I8_W_SCALE, true>(args.in[26], DM, DFF, WGU2, MapGU{1}, args.in[24], scr, gw, ngw, lane, nullptr, 1 << 30, WGU2_DEF1, 1 << 30);
        transpose_all(args.in[6], DM, 3288, WIN, MapWin{}, args.in[5], scr, gw, ngw, lane);
        for (int i = bid * NTHREADS + tid; i < 40 * 256; i += G * NTHREADS) ((u32x4*)(WIN + (size_t)3032 * DM))[i] = (u32x4){0u, 0u, 0u, 0u};
        for (int it = bid; it < 2 * NBIASP; it += G) {
            const int kv = it / NBIASP, p = it % NBIASP; const float* pos = args.in[kv ? 12 : 9]; const float* w1 = args.in[kv ? 13 : 10];
            if (tid < 256) { float s = 0.f;
                for (int k0 = 128 * p; k0 < 128 * p + 128; k0 += 32) {
                    float wv[32];
#pragma unroll
                    for (int j = 0; j < 32; ++j) wv[j] = w1[(size_t)(k0 + j) * 256 + tid];
#pragma unroll
                    for (int j = 0; j < 32; ++j) s += pos[k0 + j] * wv[j]; }
                BIASP[(kv * NBIASP + p) * 256 + tid] = s; }
        }
        for (int i = bid * NTHREADS + tid; i < SEQ * 32; i += G * NTHREADS) {
            const int p = i >> 5, f = i & 31; const float inv = powf(10000.0f, -(float)f / 32.0f); const float ang = (float)p * inv;
            ROPE[2 * i] = cosf(ang); ROPE[2 * i + 1] = sinf(ang);
        }
        for (int r = gw; r < T; r += ngw) rmsnorm_row2048_i8(x + (size_t)r * DM, args.in[1], (unsigned char*)H + (size_t)r * DM, lane);
    }
    SEAM(0);
    PH(1) { size_t wsz_ = 0; asm volatile("" : "+s"(wsz_)); unsigned char* ws = args.ws + wsz_;     int tid = threadIdx.x; asm volatile("" : "+v"(tid)); const int lane = tid & 63, wid = tid >> 6, gw = bid * 8 + wid; (void)lane; (void)gw;
        pg8::TileOrder S; S.init(H, WGU1, DM / 2, DM / 2, T, 2 * DFF, G, bid);
        pg8::gemm_phase<pg8::EpiSwiglu, pg8::TileOrder, true, false, 0, 2>(ldsp, pg8::Gemm{DM / 2, DM / 2, DM / 2}, S, pg8::EpiSwiglu{ACT, nullptr, 1.0f / (I8_H1_SCALE * (float)I8_W_SCALE)});
        {   int t2 = threadIdx.x; asm volatile("" : "+v"(t2)); const int lane2 = t2 & 63, wid2 = t2 >> 6;
            const bool conv = (G != 256) || bid >= 128; const int gwc = (G == 256) ? (bid - 128) * 8 + wid2 : bid * 8 + wid2, ngwc = (G == 256) ? 1024 : ngw;
            if (conv) { transpose_all(args.in[4], DFF, DM, WD1, MapId{0}, nullptr, (float*)lds + wid2 * (64 * 33), gwc, ngwc, lane2);
                transpose_all<MapGU, I8_W_SCALE, true>(args.in[26], DM, DFF, WGU2, MapGU{1}, args.in[24], (float*)lds + wid2 * (64 * 33), gwc, ngwc, lane2, nullptr, 1 << 30, 0, WGU2_DEF0); } }
    }
    SEAM(1);
    PH(2) { size_t wsz_ = 0; asm volatile("" : "+s"(wsz_)); unsigned char* ws = args.ws + wsz_;     int tid = threadIdx.x; asm volatile("" : "+v"(tid)); const int lane = tid & 63, wid = tid >> 6, gw = bid * 8 + wid; (void)lane; (void)gw;
        pg8::TileOrder S; S.init(ACT, WD1, DFF, DFF, T, DM, G, bid);
        pg8::gemm_phase<pg8::EpiResidStat<false, false>, pg8::TileOrder, true>(ldsp, pg8::Gemm{DFF, DFF, DFF}, S, pg8::EpiResidStat<false, false>{x, 0.5f, X1B, SS, nullptr, nullptr});
    }
    SEAML(2, 4);
    PH(4) { size_t wsz_ = 0; asm volatile("" : "+s"(wsz_)); unsigned char* ws = args.ws + wsz_;     int tid = threadIdx.x; asm volatile("" : "+v"(tid)); const int lane = tid & 63, wid = tid >> 6, gw = bid * 8 + wid; (void)lane; (void)gw;
        pg8::TileOrder S; S.init(X1B, WIN, DM, DM, T, NPROJ, G, bid);
        const pg8::EpiProj E{ws, args.in[7], args.in[8], (PG8_LAS float*)(ldsp + pg8::STAGE_BYTES)};
        pg8::gemm_phase<pg8::EpiProj, pg8::TileOrder, true>(ldsp, pg8::Gemm{DM, DM, DM}, S, E);
        {
            int t2 = tid; asm volatile("" : "+v"(t2)); const int lane2 = t2 & 63, wid2 = t2 >> 6;
            const bool sub = (G == 256); float* scr = (float*)lds + wid2 * (64 * 33);
            if (!sub || bid >= 160) { const int gw2 = sub ? (bid - 160) * 8 + wid2 : bid * 8 + wid2, ngw2 = sub ? 96 * 8 : ngw;
                transpose_all(args.in[16], 384, 1536, WUQ, MapId{0}, args.in[15], scr, gw2, ngw2, lane2, args.in[15], 1 << 30);
                transpose_all(args.in[18], 256, 2048, WUKV, MapId{0}, args.in[17], scr, gw2, ngw2, lane2, args.in[17], 1 << 30);
                transpose_all(args.in[10], 4096, 256, WC1K, MapId{0}, nullptr, scr, gw2, ngw2, lane2);
                transpose_all(args.in[13], 4096, 256, WC1V, MapId{0}, nullptr, scr, gw2, ngw2, lane2);
                transpose_all(args.in[23], DM, DM, WOUT, MapId{0}, args.in[21], scr, gw2, ngw2, lane2, args.in[22], 1024);
                transpose_all<MapGU, I8_W_SCALE, true>(args.in[26], DM, DFF, WGU2, MapGU{1}, args.in[24], scr, gw2, ngw2, lane2, nullptr, 1 << 30, WGU2_DEF0, WGU2_DEF1);
                transpose_all<MapGU, I8_W_SCALE, true>(args.in[25], DM, DFF, WGU2, MapGU{0}, args.in[24], scr, gw2, ngw2, lane2, nullptr, 1 << 30, 0, WGU2_GDEF); } }
    }
    SEAM(4);
    PH(6) { size_t wsz_ = 0; asm volatile("" : "+s"(wsz_)); unsigned char* ws = args.ws + wsz_;     int tid = threadIdx.x; asm volatile("" : "+v"(tid)); const int lane = tid & 63, wid = tid >> 6, gw = bid * 8 + wid; (void)lane; (void)gw;
#ifndef P6SUB
#define P6SUB 7
#endif
#if P6_MERGED
        {   const P6Order S{CQ, WUQ, CKV, WUKV, KCMP, VCMP, WC1K, WC1V, G, bid};
            const pg8::EpiP6 E{pg8::EpiBf16{QM, 1536, (const float*)(ws + WS_SSQCQ)}, pg8::EpiKV{ws, args.in[20], (PG8_LAS float*)(ldsp + pg8::STAGE_BYTES)}, pg8::EpiSlab{(float*)(ws + WS_CSLAB)}};
            pg8::gemm_phase<pg8::EpiP6, P6Order, true, true>(ldsp, pg8::Gemm{384, 384, 384}, S, E); }
#else
        if (bid < 2 && tid < 256) { float sb = 0.f; for (int pp = 0; pp < NBIASP; ++pp) sb += BIASP[(bid * NBIASP + pp) * 256 + tid]; BIAS1[bid * 256 + tid] = sb; }
        {   pg8::TileOrder S; S.init(CQ, WUQ, 384, 384, T, 1536, G, bid);
            pg8::gemm_phase<pg8::EpiBf16, pg8::TileOrder, true>(ldsp, pg8::Gemm{384, 384, 384}, S, pg8::EpiBf16{QM, 1536, (const float*)(ws + WS_SSQCQ)});
            if (G == 256 && bid >= 192) { int t2 = tid; asm volatile("" : "+v"(t2)); const int lane2 = t2 & 63, wid2 = t2 >> 6;
                transpose_all<MapGU, I8_W_SCALE, true>(args.in[25], DM, DFF, WGU2, MapGU{0}, args.in[24], (float*)lds + wid2 * (64 * 33), (bid - 192) * 8 + wid2, 512, lane2, nullptr, 1 << 30, WGU2_GDEF, WGU2_GQ);
                __syncthreads(); } }
        {   pg8::TileOrder S; S.init(CKV, WUKV, 256, 256, T, 2048, G, bid);
            pg8::gemm_phase<pg8::EpiKV, pg8::TileOrder, true>(ldsp, pg8::Gemm{256, 256, 256}, S, pg8::EpiKV{ws, args.in[20], (PG8_LAS float*)(ldsp + pg8::STAGE_BYTES)}); }
        {   const CmpOrder S{KCMP, VCMP, WC1K, WC1V, G, bid};
            pg8::gemm_phase<pg8::EpiSlab, CmpOrder, true>(ldsp, pg8::Gemm{2048, 4096, 4096 / NSPLIT}, S, pg8::EpiSlab{(float*)(ws + WS_CSLAB)});
            {   int t2 = tid; asm volatile("" : "+v"(t2)); const int lane2 = t2 & 63, wid2 = t2 >> 6;
                if (G == 256 && bid >= 128) transpose_all<MapGU, I8_W_SCALE, true>(args.in[25], DM, DFF, WGU2, MapGU{0}, args.in[24], (float*)lds + wid2 * (64 * 33), (bid - 128) * 8 + wid2, 1024, lane2, nullptr, 1 << 30, WGU2_GQ, WGU2_GC);
                else if (G != 256) transpose_all<MapGU, I8_W_SCALE, true>(args.in[25], DM, DFF, WGU2, MapGU{0}, args.in[24], (float*)lds + wid2 * (64 * 33), bid * 8 + wid2, ngw, lane2, nullptr, 1 << 30, WGU2_GDEF, WGU2_GC); } }
#endif
    }
    do { if (IN(6) && IN(8)) { if (G == 256 && local_ok) xcd_arrive2(xbar); else xcd_barrier(xbar); } } while (0);
    PH(8) { size_t wsz_ = 0; asm volatile("" : "+s"(wsz_)); unsigned char* ws = args.ws + wsz_;     int tid = threadIdx.x; asm volatile("" : "+v"(tid)); const int lane = tid & 63, wid = tid >> 6, gw = bid * 8 + wid; (void)lane; (void)gw;
        const CmpFinalize mid{ws, args.in[11], args.in[14], args.in[8], lds};
#ifndef P8SUB
#define P8SUB 3
#endif
        for (int c = bid; c < 256; c += G) { const int bg = c & 7, qt = c >> 3; if (P8SUB & 1) att::nsa_unit<0>(lds, bg >> 1, bg & 1, qt, ws); }
        mid();
        for (int c = bid; c < 256; c += G) {
            const int bg = c & 7, qt = c >> 3;
            if (P8SUB & 1) att::nsa_unit<1>(lds, bg >> 1, bg & 1, qt, ws);
            const int bh = bg * 4 + ((31 - qt) & 3), qb = (31 - qt) >> 2;
            if (P8SUB & 2) att::mla_unit(lds, bh >> 3, bh & 7, qb, QM, KM, VM, args.in[19], ROPE, SSO, H);
        }
    }
    SEAM(8);
    PH(10) { size_t wsz_ = 0; asm volatile("" : "+s"(wsz_)); unsigned char* ws = args.ws + wsz_;     int tid = threadIdx.x; asm volatile("" : "+v"(tid)); const int lane = tid & 63, wid = tid >> 6, gw = bid * 8 + wid; (void)lane; (void)gw;
        pg8::TileOrder S; S.init(H, WOUT, DM, DM, T, DM, G, bid);
        pg8::gemm_phase<pg8::EpiResidStat<true, true>, pg8::TileOrder, true>(ldsp, pg8::Gemm{DM, DM, DM}, S, pg8::EpiResidStat<true, true>{X1B, 1.0f, H2, SS, SSO, H2F8});
    }
    SEAML(10, 12);
    PH(12) { size_t wsz_ = 0; asm volatile("" : "+s"(wsz_)); unsigned char* ws = args.ws + wsz_;     int tid = threadIdx.x; asm volatile("" : "+v"(tid)); const int lane = tid & 63, wid = tid >> 6, gw = bid * 8 + wid; (void)lane; (void)gw;
        {   int t2 = threadIdx.x; asm volatile("" : "+v"(t2)); const int lane2 = t2 & 63, wid2 = t2 >> 6;
            const bool conv = (G != 256) || bid >= 128; const int gwc = (G == 256) ? (bid - 128) * 8 + wid2 : bid * 8 + wid2, ngwc = (G == 256) ? 1024 : ngw;
            if (conv) transpose_all<MapId, F8_WD_SCALE>(args.in[27], DFF, DM, WD2, MapId{0}, nullptr, (float*)lds + wid2 * (64 * 33), gwc, ngwc, lane2); }
        xcd_arrive_s(xbar, XB_SET(3));
        pg8::TileOrder S; S.init((const bf16_t*)H2F8, WGU2, DM / 2, DM / 2, T, 2 * DFF, G, bid);
        pg8::gemm_phase<pg8::EpiSwigluT<true, true>, pg8::TileOrder, true, false, 0, 2>(ldsp, pg8::Gemm{DM / 2, DM / 2, DM / 2}, S, pg8::EpiSwigluT<true, true>{ACT, SS, 1.0f / (I8_X2_SCALE * (float)I8_W_SCALE)});
    }
    do { if (IN(12) && IN(13)) { if (local_ok) { xcd_wait_s(xbar, XB_SET(3), false); xcd_barrier_local(xbar); } else xcd_barrier(xbar); } } while (0);
    PH(13) { size_t wsz_ = 0; asm volatile("" : "+s"(wsz_)); unsigned char* ws = args.ws + wsz_;     int tid = threadIdx.x; asm volatile("" : "+v"(tid)); const int lane = tid & 63, wid = tid >> 6, gw = bid * 8 + wid; (void)lane; (void)gw;
        pg8::TileOrder S; S.init(ACT, WD2, DFF / 2, DFF / 2, T, DM, G, bid);
        pg8::gemm_phase<pg8::EpiResid, pg8::TileOrder, true, false, 0, 1>(ldsp, pg8::Gemm{DFF / 2, DFF / 2, DFF / 2}, S, pg8::EpiResid{H2, out, 0.5f / ((float)F8_WD_SCALE * F8_ASCALE)});
    }
#ifdef PROBE_ID
    cg::this_grid().sync();
    if (PROBE_ID == 1) { pg8::TileOrder S; S.init(H2, WGU2, DM, DM, T, 2 * DFF, G, bid); pg8::gemm_phase<pg8::EpiNull, pg8::TileOrder, true>(ldsp, pg8::Gemm{DM, DM, DM}, S, pg8::EpiNull{}); }
    if (PROBE_ID == 2) { pg8::TileOrder S; S.init(ACT, WD2, DFF, DFF, T, DM, G, bid); pg8::gemm_phase<pg8::EpiNull, pg8::TileOrder, true>(ldsp, pg8::Gemm{DFF, DFF, DFF}, S, pg8::EpiNull{}); }
    if (PROBE_ID == 3) { }
    if (PROBE_ID == 16) { pg8::TileOrder S; S.init(ACT, WD2, DFF / 2, DFF / 2, T, DM, G, bid); pg8::gemm_phase<pg8::EpiNull, pg8::TileOrder, true, false, 0, true>(ldsp, pg8::Gemm{DFF / 2, DFF / 2, DFF / 2}, S, pg8::EpiNull{}); }
    if (PROBE_ID == 17) { pg8::TileOrder S; S.init(ACT, WD2, DFF / 2, DFF / 2, T, DM, G, bid); pg8::gemm_phase<pg8::EpiNull, pg8::TileOrder, true, false, 1, true>(ldsp, pg8::Gemm{DFF / 2, DFF / 2, DFF / 2}, S, pg8::EpiNull{}); }
    if (PROBE_ID == 18) { pg8::TileOrder S; S.init(ACT, WD2, DFF / 2, DFF / 2, T, DM, G, bid); pg8::gemm_phase<pg8::EpiNull, pg8::TileOrder, true, false, 2, true>(ldsp, pg8::Gemm{DFF / 2, DFF / 2, DFF / 2}, S, pg8::EpiNull{}); }
    if (PROBE_ID == 14) { pg8::TileOrder S; S.init(H2, WGU2, DM, DM, T, 2 * DFF, G, bid); pg8::gemm_phase<pg8::EpiNull, pg8::TileOrder, true, false, 1>(ldsp, pg8::Gemm{DM, DM, DM}, S, pg8::EpiNull{}); }
    if (PROBE_ID == 15) { pg8::TileOrder S; S.init(H2, WGU2, DM, DM, T, 2 * DFF, G, bid); pg8::gemm_phase<pg8::EpiNull, pg8::TileOrder, true, false, 2>(ldsp, pg8::Gemm{DM, DM, DM}, S, pg8::EpiNull{}); }
    if (PROBE_ID == 13) { int tid = threadIdx.x; asm volatile("" : "+v"(tid)); const int lane = tid & 63, wid = tid >> 6, gw = bid * 8 + wid;
        float* hid = (float*)lds + wid * 256;
        for (int rid = gw; rid < 2 * NB * 2 * 128; rid += ngw) {
            const int n = rid & 127, g = (rid >> 7) & 1, b = (rid >> 8) & 3, kv = rid >> 10;
            bf16_t* dst = (kv ? VC : KC) + (((size_t)b * 2 + g) * 128 + n) * 128;
            if (n == 127) { *(unsigned*)(dst + 2 * lane) = 0u; continue; }
            const float* w2 = args.in[kv ? 14 : 11];
#pragma unroll
            for (int i = 0; i < 4; ++i) {
                const int k = lane + 64 * i; float a = 0.f;
                for (int sp = 0; sp < NSPLIT; ++sp) a += SLAB[((size_t)((kv * 2 + g) * NSPLIT + sp) * 512 + b * 128 + n) * 256 + k];
                a += BIAS1[kv * 256 + k];
                const float t3 = 0.7978845608028654f * (a + 0.044715f * a * a * a);
                hid[k] = 0.5f * a * (1.0f + tanhf(t3));
            }
            __builtin_amdgcn_s_waitcnt(0xc07f); asm volatile("" ::: "memory");
            float o0 = 0.f, o1 = 0.f;
            for (int k = 0; k < 256; ++k) { const float hk = hid[k]; const f32x2 w = *(const f32x2*)(w2 + (size_t)k * 128 + 2 * lane); o0 += hk * w.x; o1 += hk * w.y; }
            if (kv == 0) { const float* kg0 = args.in[8]; const float rr = 1.0f / sqrtf(wave_sum(o0 * o0 + o1 * o1) * (1.0f / 128.0f) + EPS); o0 *= rr * kg0[2 * lane]; o1 *= rr * kg0[2 * lane + 1]; }
            *(unsigned*)(dst + 2 * lane) = pk2(o0, o1);
            __builtin_amdgcn_s_waitcnt(0xc07f); asm volatile("" ::: "memory");
        }
        }

    if (PROBE_ID == 9) {
        {   pg8::TileOrder S; S.init(CQ, WUQ, 384, 384, T, 1536, G, bid);
            pg8::gemm_phase<pg8::EpiBf16, pg8::TileOrder, true>(ldsp, pg8::Gemm{384, 384, 384}, S, pg8::EpiBf16{QM, 1536, (const float*)(ws + WS_SSQCQ)}); }
        {   pg8::TileOrder S; S.init(CKV, WUKV, 256, 256, T, 2048, G, bid);
            pg8::gemm_phase<pg8::EpiKV, pg8::TileOrder, true>(ldsp, pg8::Gemm{256, 256, 256}, S, pg8::EpiKV{ws, args.in[20], (PG8_LAS float*)(ldsp + pg8::STAGE_BYTES)}); }
        {   const CmpOrder S{KCMP, VCMP, WC1K, WC1V, G, bid};
            pg8::gemm_phase<pg8::EpiSlab, CmpOrder, true>(ldsp, pg8::Gemm{2048, 4096, 4096 / NSPLIT}, S, pg8::EpiSlab{(float*)(ws + WS_CSLAB)}); } }
    if (PROBE_ID == 10) { pg8::TileOrder S; S.init(H, WOUT, DM, DM, T, DM, G, bid);
        pg8::gemm_phase<pg8::EpiResidStat<true, true>, pg8::TileOrder, true>(ldsp, pg8::Gemm{DM, DM, DM}, S, pg8::EpiResidStat<true, true>{X1B, 1.0f, H2, SS, SSO, H2F8}); }
    if (PROBE_ID == 11) { pg8::TileOrder S; S.init(ACT, WD2, DFF, DFF, T, DM, G, bid);
        pg8::gemm_phase<pg8::EpiResid, pg8::TileOrder, true>(ldsp, pg8::Gemm{DFF, DFF, DFF}, S, pg8::EpiResid{H2, out, 0.5f}); }
    if (PROBE_ID == 12) { for (int c = bid; c < 256; c += G) { const int bg = c & 7, qt = c >> 3; att::nsa_unit<2>(lds, bg >> 1, bg & 1, qt, ws);
            const int bh = bg * 4 + ((31 - qt) & 3), qb = (31 - qt) >> 2; att::mla_unit(lds, bh >> 3, bh & 7, qb, QM, KM, VM, args.in[19], ROPE, SSO, H); } }
    if (PROBE_ID == 6) { for (int c = bid; c < 256; c += G) { const int bg = c & 7; att::nsa_unit<2>(lds, bg >> 1, bg & 1, 0, ws); } }
    if (PROBE_ID == 7) { for (int c = bid; c < 256; c += G) { const int bg = c & 7; att::nsa_unit<2>(lds, bg >> 1, bg & 1, 16, ws); } }
    if (PROBE_ID == 8) { for (int c = bid; c < 256; c += G) { const int bg = c & 7; const int bh = bg * 4 + ((c >> 3) & 3); att::mla_unit(lds, bh >> 3, bh & 7, 0, QM, KM, VM, args.in[19], ROPE, SSO, H); } }
    if (PROBE_ID == 4) { for (int c = bid; c < 256; c += G) { const int bg = c & 7, qt = c >> 3; att::nsa_unit<2>(lds, bg >> 1, bg & 1, qt, ws); } }
    if (PROBE_ID == 5) { for (int c = bid; c < 256; c += G) { const int bg = c & 7, qt = c >> 3; const int bh = bg * 4 + ((31 - qt) & 3), qb = (31 - qt) >> 2; att::mla_unit(lds, bh >> 3, bh & 7, qb, QM, KM, VM, args.in[19], ROPE, SSO, H); } }
#endif
#undef WGU1
#undef WD1
#undef WGU2
#undef WD2
#undef WIN
#undef WOUT
#undef WUQ
#undef WUKV
#undef WC1K
#undef WC1V
#undef H
#undef ACT
#undef PROJ
#undef QM
#undef KNRAW
#undef KM
#undef VM
#undef QN
#undef KS
#undef VS
#undef KW
#undef VW
#undef KCMP
#undef VCMP
#undef CQ
#undef CKV
#undef KROPE
#undef GATES
#undef KC
#undef VC
#undef SS
#undef SSO
#undef H2
#undef BIASP
#undef ROPE
#undef SLAB
#undef X1B
#undef BIAS1
#undef IN
#undef SEAM
}

constexpr int NPHASES = 14;

extern "C" void kernel_launch(void* const* d_in, const int* in_sizes, int n_in, void* d_out, int out_size, void* d_ws, size_t ws_size, hipStream_t stream) {
    static int grid = 0;
    if (grid == 0) {
        if (n_in != 28 || out_size != T * DM || ws_size < WS_END) { fprintf(stderr, "kernel_launch: unexpected shapes: n_in %d out %d ws %zu (need %zu)\n", n_in, out_size, ws_size, (size_t)WS_END); grid = -1; return; }
        int dev = 0, cus = 0, per_cu = 0;
        (void)hipGetDevice(&dev); (void)hipDeviceGetAttribute(&cus, hipDeviceAttributeMultiprocessorCount, dev);
        (void)hipFuncSetAttribute((const void*)mega, hipFuncAttributeMaxDynamicSharedMemorySize, LDS_BYTES);
        (void)hipOccupancyMaxActiveBlocksPerMultiprocessor(&per_cu, (const void*)mega, NTHREADS, LDS_BYTES);
        if (per_cu < 1) { fprintf(stderr, "kernel_launch: occupancy query says %d blocks per CU\n", per_cu); per_cu = 1; }
        (void)hipGetLastError();
        grid = cus;
        if (cus != 256) { fprintf(stderr, "kernel_launch: built for a 256-CU device (one 256x256 unit per workgroup in the fused-epilogue phases); found %d CUs\n", cus); grid = -1; return; }
        fprintf(stderr, "kernel_launch: grid %d (cus %d, per_cu %d), ws %zu\n", grid, cus, per_cu, ws_size);
    }
    if (grid < 0) return;
    Args a{};
    for (int i = 0; i < 28; ++i) a.in[i] = (const float*)d_in[i];
    a.out = (float*)d_out; a.ws = (unsigned char*)d_ws;
#if MK_ONE_LAUNCH
    a.ph_lo = 0; a.ph_hi = NPHASES;
#if MK_NO_CG == 1
    (void)hipMemsetAsync((unsigned char*)d_ws + WS_BAR, 0, XCD_BAR_WORDS * 4, stream);
    hipLaunchKernelGGL(mega, dim3(grid), dim3(NTHREADS), LDS_BYTES, stream, a);
#elif MK_NO_CG == 2
    (void)hipMemsetAsync((unsigned char*)d_ws + WS_BAR, 0, XCD_BAR_WORDS * 4, stream);
    {   void* kargs[] = {&a};
        hipError_t e = hipLaunchCooperativeKernel((const void*)mega, dim3(grid), dim3(NTHREADS), kargs, LDS_BYTES, stream);
        if (e != hipSuccess) fprintf(stderr, "cooperative launch failed: %s\n", hipGetErrorString(e)); }
#else
    void* kargs[] = {&a};
    hipError_t e = hipLaunchCooperativeKernel((const void*)mega, dim3(grid), dim3(NTHREADS), kargs, LDS_BYTES, stream);
    if (e != hipSuccess) fprintf(stderr, "cooperative launch failed: %s\n", hipGetErrorString(e));
#endif
#else
    for (int p = 0; p < NPHASES; ++p) {
        a.ph_lo = p; a.ph_hi = p + 1;
        hipLaunchKernelGGL(mega, dim3(grid), dim3(NTHREADS), LDS_BYTES, stream, a);
    }
#endif
}
```

```cpp
#include <hip/hip_runtime.h>
#include <hip/hip_cooperative_groups.h>
#include <cstdio>
#include <cstdint>
namespace cg = cooperative_groups;

#ifndef MK_ONE_LAUNCH
#define MK_ONE_LAUNCH 1
#endif
#ifndef MK_NO_CG
#define MK_NO_CG 2
#endif

#define DI __device__ __forceinline__
typedef unsigned short bf16_t;
typedef short bf16x8 __attribute__((ext_vector_type(8)));
typedef float f32x4 __attribute__((ext_vector_type(4)));
typedef float f32x2 __attribute__((ext_vector_type(2)));
typedef unsigned u32x4 __attribute__((ext_vector_type(4)));
typedef unsigned u32x2 __attribute__((ext_vector_type(2)));

constexpr int NB = 4, SEQ = 2048, DM = 2048, T = NB * SEQ, DFF = 5632;
constexpr int NPROJ = 3328;
constexpr int PC_Q = 0, PC_KCMP = 1024, PC_VCMP = 1280, PC_KSEL = 1536, PC_VSEL = 1792, PC_KWIN = 2048, PC_VWIN = 2304,
              PC_CQ = 2560, PC_KROPE = 2944, PC_GATE = 3008, PC_CKV = 3072;
constexpr float EPS = 1e-6f;
constexpr int NSPLIT = 16;
constexpr int NBIASP = 32;
constexpr int WGU2_DEF0 = 4200, WGU2_DEF1 = 5632, WGU2_GDEF = 1600, WGU2_GQ = 2800, WGU2_GC = 4800;

constexpr size_t MiB = 1u << 20;
constexpr size_t WS_CTL = 0;
constexpr size_t WS_SS = 0;
constexpr size_t WS_BAR = 768 * 1024;
constexpr size_t WS_SSO = 256 * 1024;
constexpr size_t WS_WGU1 = 1 * MiB;
constexpr size_t WS_CSLAB = WS_WGU1 + 22 * MiB;
constexpr size_t WS_WD1 = WS_WGU1 + 44 * MiB;
constexpr size_t WS_WGU2 = WS_WD1 + 22 * MiB;
constexpr size_t WS_WD2 = WS_WGU2 + 44 * MiB;
constexpr size_t WS_WIN = WS_WD2 + 22 * MiB;
constexpr size_t WS_WOUT = WS_WIN + 13 * MiB;
constexpr size_t WS_WUQ = WS_WOUT + 8 * MiB;
constexpr size_t WS_WUKV = WS_WUQ + 2 * MiB;
constexpr size_t WS_WC1K = WS_WUKV + 1 * MiB;
constexpr size_t WS_WC1V = WS_WC1K + 2 * MiB;
constexpr size_t WS_H = WS_WC1V + 2 * MiB;
constexpr size_t WS_R1 = WS_H + 32 * MiB;
constexpr size_t WS_ACT = WS_R1;
constexpr size_t WS_PROJ = WS_R1;
constexpr size_t WS_QM = WS_R1;
constexpr size_t WS_KNRAW = WS_QM + 24 * MiB;
constexpr size_t WS_KM = WS_KNRAW + 16 * MiB;
constexpr size_t WS_VM = WS_KM + 24 * MiB;
constexpr size_t WS_R2 = WS_R1 + 88 * MiB;
constexpr size_t WS_H2 = WS_R2;
constexpr size_t WS_QN = WS_R2;
constexpr size_t WS_KS = WS_QN + 16 * MiB;
constexpr size_t WS_VS = WS_KS + 4 * MiB;
constexpr size_t WS_KW = WS_VS + 4 * MiB;
constexpr size_t WS_VW = WS_KW + 4 * MiB;
constexpr size_t WS_KCMP = WS_VW + 4 * MiB;
constexpr size_t WS_VCMP = WS_KCMP + 5 * MiB;
constexpr size_t WS_CQ = WS_VCMP + 5 * MiB;
constexpr size_t WS_CKV = WS_CQ + 6 * MiB;
constexpr size_t WS_KROPE = WS_CKV + 4 * MiB;
constexpr size_t WS_GATES = WS_KROPE + 2 * MiB;
constexpr size_t WS_KC = WS_GATES + 1 * MiB;
constexpr size_t WS_VC = WS_KC + 512 * 1024;
constexpr size_t WS_BIASP = WS_VC + 512 * 1024;
constexpr size_t WS_SSQCQ = WS_BIASP + 128 * 1024;
constexpr size_t WS_SSQCKV = WS_BIASP + 576 * 1024;
constexpr size_t WS_SSQKR = WS_BIASP + 896 * 1024;
constexpr size_t WS_ROPE = WS_BIASP + 1 * MiB;
constexpr size_t WS_SLAB = WS_ROPE + 1 * MiB;
constexpr size_t WS_END = WS_SLAB + 32 * MiB;
static_assert(WS_END <= 380 * MiB, "workspace map too large");

constexpr int LDS_BYTES = 147456;
constexpr int NTHREADS = 512;

DI float bf2f(bf16_t v) { return __uint_as_float((unsigned)v << 16); }
DI unsigned f2bf(float f) { unsigned u = __float_as_uint(f); return (u + 0x7fffu + ((u >> 16) & 1u)) >> 16; }
DI unsigned pk2(float lo, float hi) { return f2bf(lo) | (f2bf(hi) << 16); }
DI float lo2f(unsigned w) { return __uint_as_float(w << 16); }
DI float hi2f(unsigned w) { return __uint_as_float(w & 0xffff0000u); }
DI float wave_sum(float v) {
#pragma unroll
    for (int o = 1; o < 64; o <<= 1) v += __shfl_xor(v, o);
    return v;
}
DI float wave_max(float v) {
#pragma unroll
    for (int o = 1; o < 64; o <<= 1) v = fmaxf(v, __shfl_xor(v, o));
    return v;
}

DI int opaque_int(int v) { asm volatile("" : "+s"(v)); return v; }
struct Args {
    const float* in[28];
    float* out;
    unsigned char* ws;
    int ph_lo, ph_hi;
};

struct MapId { int off; DI int operator()(int n) const { return n + off; } };
struct MapGU { int half; DI int operator()(int n) const { return (n >> 7) * 256 + half * 128 + (n & 127); } };
struct MapWin {
    DI int operator()(int n) const {
        if (n < 2560) return n;
        if (n < 2584) return PC_GATE + (n - 2560);
        if (n < 2968) return PC_CQ + (n - 2584);
        if (n < 3224) return PC_CKV + (n - 2968);
        return PC_KROPE + (n - 3224);
    }
};
DI unsigned pk4_fp8(float a, float b, float c, float d) {
    int w = 0;
    w = __builtin_amdgcn_cvt_pk_fp8_f32(__builtin_amdgcn_fmed3f(a, -448.f, 448.f), __builtin_amdgcn_fmed3f(b, -448.f, 448.f), w, false);
    w = __builtin_amdgcn_cvt_pk_fp8_f32(__builtin_amdgcn_fmed3f(c, -448.f, 448.f), __builtin_amdgcn_fmed3f(d, -448.f, 448.f), w, true);
    return (unsigned)w;
}
DI unsigned pk4_i8(float a, float b, float c, float d) {
    unsigned w = 0;
    w = __builtin_amdgcn_cvt_pk_u8_f32(__builtin_rintf(a) + 128.f, 0, w); w = __builtin_amdgcn_cvt_pk_u8_f32(__builtin_rintf(b) + 128.f, 1, w);
    w = __builtin_amdgcn_cvt_pk_u8_f32(__builtin_rintf(c) + 128.f, 2, w); w = __builtin_amdgcn_cvt_pk_u8_f32(__builtin_rintf(d) + 128.f, 3, w);
    return w ^ 0x80808080u;
}
constexpr int F8_WD_SCALE = 2048; constexpr float F8_ASCALE = 16.0f;
constexpr int I8_W_SCALE = 1437;
constexpr float I8_H1_SCALE = 31.75f, I8_X2_SCALE = 20.0f;
template <class Map, int F8S = 0, bool I8 = false>
DI void transpose_all(const float* W, int K, int N, bf16_t* WT, const Map& map, const float* gain, float* scr, int gw, int ngw, int lane, const float* gain2 = nullptr, int gsplit = 1 << 30, int it0 = 0, int it1 = 1 << 30) {
    const int nblk = (N + 31) / 32, nitems = min((K / 64) * nblk, it1);
    float v[32];
    int it = it0 + gw;
#define TR_LOAD(item) do { const int kb_ = (item) / nblk, nb_ = (item) % nblk; const int nl_ = 32 * nb_ + (lane & 31); const float* wp_ = W + (size_t)(64 * kb_ + (lane >> 5)) * N + nl_; \
        _Pragma("unroll") for (int i = 0; i < 32; ++i) v[i] = (nl_ < N) ? wp_[(size_t)(2 * i) * N] : 0.f; } while (0)
    if (it < nitems) TR_LOAD(it);
    for (; it < nitems; it += ngw) {
        const int kb = it / nblk, nb = it % nblk, k0 = 64 * kb, n0 = 32 * nb;
        if (gain) {
            const float* gp = (k0 < gsplit) ? gain + k0 : gain2 + (k0 - gsplit);
#pragma unroll
            for (int i = 0; i < 32; ++i) v[i] *= gp[2 * i + (lane >> 5)];
        }
#pragma unroll
        for (int i = 0; i < 32; ++i) scr[(2 * i + (lane >> 5)) * 33 + (lane & 31)] = v[i];
        const int itn = it + ngw;
        if (itn < nitems) TR_LOAD(itn);
        __builtin_amdgcn_s_waitcnt(0xc07f); asm volatile("" ::: "memory");
        const int c = lane & 7;
#pragma unroll
        for (int j = 0; j < 4; ++j) {
            const int n = (lane >> 3) + 8 * j; const float* sp = scr + (8 * c) * 33 + n;
            if constexpr (F8S != 0) { constexpr float F8_WSCALE = (float)F8S;
                u32x2 o;
                if constexpr (I8) { o.x = pk4_i8(sp[0 * 33] * F8_WSCALE, sp[1 * 33] * F8_WSCALE, sp[2 * 33] * F8_WSCALE, sp[3 * 33] * F8_WSCALE);
                    o.y = pk4_i8(sp[4 * 33] * F8_WSCALE, sp[5 * 33] * F8_WSCALE, sp[6 * 33] * F8_WSCALE, sp[7 * 33] * F8_WSCALE); }
                else { o.x = pk4_fp8(sp[0 * 33] * F8_WSCALE, sp[1 * 33] * F8_WSCALE, sp[2 * 33] * F8_WSCALE, sp[3 * 33] * F8_WSCALE);
                    o.y = pk4_fp8(sp[4 * 33] * F8_WSCALE, sp[5 * 33] * F8_WSCALE, sp[6 * 33] * F8_WSCALE, sp[7 * 33] * F8_WSCALE); }
                if (n0 + n < N) *(u32x2*)((unsigned char*)WT + (size_t)map(n0 + n) * K + k0 + 8 * c) = o;
            } else {
            u32x4 o; o.x = pk2(sp[0 * 33], sp[1 * 33]); o.y = pk2(sp[2 * 33], sp[3 * 33]); o.z = pk2(sp[4 * 33], sp[5 * 33]); o.w = pk2(sp[6 * 33], sp[7 * 33]);
            if (n0 + n < N) *(u32x4*)(WT + (size_t)map(n0 + n) * K + k0 + 8 * c) = o; }
        }
        __builtin_amdgcn_s_waitcnt(0xc07f); asm volatile("" ::: "memory");
    }
#undef TR_LOAD
}

DI void rmsnorm_row2048_i8(const float* xrow, const float* g, unsigned char* orow, int lane) {
    f32x4 v[8]; float ss = 0.f;
#pragma unroll
    for (int j = 0; j < 8; ++j) { v[j] = *(const f32x4*)(xrow + 256 * j + 4 * lane); ss += (v[j].x * v[j].x + v[j].y * v[j].y) + (v[j].z * v[j].z + v[j].w * v[j].w); }
    const float r = I8_H1_SCALE / sqrtf(wave_sum(ss) * (1.0f / 2048.0f) + EPS);
#pragma unroll
    for (int j = 0; j < 8; ++j) {
        const f32x4 gg = *(const f32x4*)(g + 256 * j + 4 * lane);
        *(unsigned*)(orow + 256 * j + 4 * lane) = pk4_i8(v[j].x * r * gg.x, v[j].y * r * gg.y, v[j].z * r * gg.z, v[j].w * r * gg.w);
    }
}
DI void rmsnorm_row2048(const float* xrow, const float* g, bf16_t* orow, int lane) {
    f32x4 v[8]; float ss = 0.f;
#pragma unroll
    for (int j = 0; j < 8; ++j) { v[j] = *(const f32x4*)(xrow + 256 * j + 4 * lane); ss += (v[j].x * v[j].x + v[j].y * v[j].y) + (v[j].z * v[j].z + v[j].w * v[j].w); }
    const float r = 1.0f / sqrtf(wave_sum(ss) * (1.0f / 2048.0f) + EPS);
#pragma unroll
    for (int j = 0; j < 8; ++j) {
        const f32x4 gg = *(const f32x4*)(g + 256 * j + 4 * lane);
        u32x2 o; o.x = pk2(v[j].x * r * gg.x, v[j].y * r * gg.y); o.y = pk2(v[j].z * r * gg.z, v[j].w * r * gg.w);
        *(u32x2*)(orow + 256 * j + 4 * lane) = o;
    }
}

#ifndef P6_MERGED
#define P6_MERGED 0
#endif
#ifndef PG8_SP2
#define PG8_SP2 1
#endif
namespace pg8 {
#define PG8_LAS __attribute__((address_space(3)))
constexpr int BM = 256, BK = 64, HALF = 128, HTB = HALF * BK * 2, STAGE_BYTES = 8 * HTB, NXCD = 8, WGM = 4;
DI int lds_byte(int r, int c) { const int st = (r >> 4) * 2 + (c >> 5), rr = r & 15, cc = c & 31, ob = rr * 64 + cc * 2; return st * 1024 + (ob ^ (((ob >> 9) & 1) << 5)); }
DI void stage_rc(int b, int& R, int& C) { const int st = b / 1024, sb = b % 1024, swz = sb ^ (((sb >> 9) & 1) << 5); R = (st >> 1) * 16 + swz / 64; C = (st & 1) * 32 + (swz % 64) / 2; }
DI int perm32(int rho) { const int n = rho >> 4, i = rho & 15; return 8 * (i >> 2) + 4 * n + (i & 3); }
struct Unit { const char* A; const char* B; int pm, pn, aux, type; };
DI int mg_lda(int t) { return t == 0 ? 768 : (t == 1 ? 512 : 4096); }
DI int mg_ldb(int t) { return t == 0 ? 768 : (t == 1 ? 512 : 8192); }
DI int mg_nt(int t) { return t == 0 ? 6 : 4; }
DI int mg_perm(int t) { return t == 2 ? 0 : 1; }
struct Gemm { long lda, ldb; int K; };

struct TileOrder {
    const bf16_t* A; const bf16_t* Bt; long lda, ldb; int nM, nN, nwg, G, c;
    DI void init(const bf16_t* A_, const bf16_t* Bt_, long lda_, long ldb_, int M, int N, int G_, int c_) { A = A_; Bt = Bt_; lda = lda_; ldb = ldb_; nM = M / BM; nN = N / BM; nwg = nM * nN; G = G_; c = c_; }
    DI bool next(int i, Unit& u) const {
        const int L = i * G + c; if (L >= nwg) return false;
        int wgid = L; { const int q = nwg / NXCD, r = nwg % NXCD, xcd = wgid % NXCD, off = wgid / NXCD; wgid = (xcd < r ? xcd * (q + 1) : r * (q + 1) + (xcd - r) * q) + off; }
        const int nig = WGM * nN, gid = wgid / nig, fm = gid * WGM, gsz = (nM - fm) < WGM ? (nM - fm) : WGM;
        u.pm = fm + ((wgid % nig) % gsz); u.pn = (wgid % nig) / gsz; u.aux = 0;
        u.A = (const char*)(A + (size_t)u.pm * BM * lda); u.B = (const char*)(Bt + (size_t)u.pn * BM * ldb); return true;
    }
};

typedef int i32x4v __attribute__((ext_vector_type(4)));
typedef int i32x8v __attribute__((ext_vector_type(8)));
DI i32x8v f8cat(bf16x8 lo, bf16x8 hi) { const i32x4v a = __builtin_bit_cast(i32x4v, lo), b = __builtin_bit_cast(i32x4v, hi); return __builtin_shufflevector(a, b, 0, 1, 2, 3, 4, 5, 6, 7); }
DI unsigned cvt_pk_bf16(float lo, float hi) { unsigned r; asm volatile("v_cvt_pk_bf16_f32 %0, %1, %2" : "=v"(r) : "v"(lo), "v"(hi)); return r; }

template <bool F8, bool I32 = false>
struct EpiSwigluT {
    static constexpr bool PERM = true, AFTER_DRAIN = false, MIDK = false;
    bf16_t* act; const float* ss; float ds;
    DI void operator()(const f32x4 (&acc)[2][2][4][2], const Unit& u, int wr, int wc, int fr, int fq) const {
#pragma unroll
        for (int ai = 0; ai < 2; ++ai)
#pragma unroll
            for (int m = 0; m < 4; ++m) {
                const int row = u.pm * BM + ai * HALF + wr * 64 + m * 16 + fr;
                float rs = ds;
                if (ss) { const f32x4 s0 = *(const f32x4*)(ss + (size_t)row * 8), s1 = *(const f32x4*)(ss + (size_t)row * 8 + 4);
                          rs = ds / sqrtf((((s0[0] + s0[1]) + (s0[2] + s0[3])) + ((s1[0] + s1[1]) + (s1[2] + s1[3]))) * (1.0f / 2048.0f) + EPS); }
                float o[8];
#pragma unroll
                for (int n = 0; n < 2; ++n)
#pragma unroll
                    for (int j = 0; j < 4; ++j) { const float g = (I32 ? (float)__float_as_int(acc[ai][0][m][n][j]) : acc[ai][0][m][n][j]) * rs, up = (I32 ? (float)__float_as_int(acc[ai][1][m][n][j]) : acc[ai][1][m][n][j]) * rs; o[4 * n + j] = g * __builtin_amdgcn_rcpf(1.0f + __expf(-g)) * up; }
                if constexpr (F8) {
                    u32x2 w; w.x = pk4_fp8(o[0] * F8_ASCALE, o[1] * F8_ASCALE, o[2] * F8_ASCALE, o[3] * F8_ASCALE); w.y = pk4_fp8(o[4] * F8_ASCALE, o[5] * F8_ASCALE, o[6] * F8_ASCALE, o[7] * F8_ASCALE);
                    *(u32x2*)((unsigned char*)act + (size_t)row * DFF + u.pn * 128 + wc * 32 + 8 * fq) = w;
                } else {
                u32x4 w; w.x = cvt_pk_bf16(o[0], o[1]); w.y = cvt_pk_bf16(o[2], o[3]); w.z = cvt_pk_bf16(o[4], o[5]); w.w = cvt_pk_bf16(o[6], o[7]);
                *(u32x4*)(act + (size_t)row * DFF + u.pn * 128 + wc * 32 + 8 * fq) = w; }
            }
    }
};
using EpiSwiglu = EpiSwigluT<false, true>;
DI f32x4 bf4_to_f32(u32x2 w) { f32x4 r; r[0] = __uint_as_float(w.x << 16); r[1] = __uint_as_float(w.x & 0xffff0000u); r[2] = __uint_as_float(w.y << 16); r[3] = __uint_as_float(w.y & 0xffff0000u); return r; }
struct EpiResid {
    static constexpr bool PERM = false, AFTER_DRAIN = false, MIDK = false;
    const bf16_t* base; float* out; float scale;
    DI void operator()(const f32x4 (&acc)[2][2][4][2], const Unit& u, int wr, int wc, int fr, int fq) const {
        const bf16_t* const base_ = base; float* const out_ = out; const float scale_ = scale; const int pm_ = u.pm, pn_ = u.pn;
#pragma unroll
        for (int ai = 0; ai < 2; ++ai) {
            u32x2 bs[4][2][2];
#pragma unroll
            for (int m = 0; m < 4; ++m) { const size_t off = (size_t)(pm_ * BM + ai * HALF + wr * 64 + m * 16 + fr) * DM + pn_ * BM + wc * 32 + 4 * fq;
#pragma unroll
                for (int bj = 0; bj < 2; ++bj)
#pragma unroll
                    for (int n = 0; n < 2; ++n) bs[m][bj][n] = *(const u32x2*)(base_ + off + bj * HALF + n * 16); }
#pragma unroll
            for (int m = 0; m < 4; ++m) { const size_t off = (size_t)(pm_ * BM + ai * HALF + wr * 64 + m * 16 + fr) * DM + pn_ * BM + wc * 32 + 4 * fq;
#pragma unroll
                for (int bj = 0; bj < 2; ++bj)
#pragma unroll
                    for (int n = 0; n < 2; ++n) *(f32x4*)(out_ + off + bj * HALF + n * 16) = bf4_to_f32(bs[m][bj][n]) + acc[ai][bj][m][n] * scale_; }
            asm volatile("" ::: "memory");
        }
    }
};
template <bool TWO_NORM, bool BASE_BF16>
struct EpiResidStat {
    static constexpr bool PERM = false, AFTER_DRAIN = true, MIDK = TWO_NORM;
    const void* base; float scale; bf16_t* hb; float* ssq; const float* sso; unsigned char* hb8;
    DI void row_norms(int row, float& ra, float& rb) const {
        const f32x4 a0 = *(const f32x4*)(sso + (size_t)row * 16), a1 = *(const f32x4*)(sso + (size_t)row * 16 + 4), b0 = *(const f32x4*)(sso + (size_t)row * 16 + 8), b1 = *(const f32x4*)(sso + (size_t)row * 16 + 12);
        ra = 1.0f / sqrtf((((a0[0] + a0[1]) + (a0[2] + a0[3])) + ((a1[0] + a1[1]) + (a1[2] + a1[3]))) * (1.0f / 1024.0f) + EPS);
        rb = 1.0f / sqrtf((((b0[0] + b0[1]) + (b0[2] + b0[3])) + ((b1[0] + b1[1]) + (b1[2] + b1[3]))) * (1.0f / 1024.0f) + EPS);
    }
    DI void midk(f32x4 (&acc)[2][2][4][2], const Unit& u, int wr, int wc, int fr, int fq) const {
#pragma unroll
        for (int ai = 0; ai < 2; ++ai)
#pragma unroll
            for (int m = 0; m < 4; ++m) { float ra, rb; row_norms(u.pm * BM + ai * HALF + wr * 64 + m * 16 + fr, ra, rb); const float f = ra / rb;
#pragma unroll
                for (int bj = 0; bj < 2; ++bj)
#pragma unroll
                    for (int n = 0; n < 2; ++n) acc[ai][bj][m][n] *= f; }
    }
    DI void fused(f32x4 (&acc)[2][2][4][2], const Unit& u, int wr, int wc, int fr, int fq, PG8_LAS unsigned char* lds, int wid, int lane) const {
        PG8_LAS float* P = (PG8_LAS float*)lds;
        const float* const basef_ = (const float*)base; const bf16_t* const baseh_ = (const bf16_t*)base; bf16_t* const hb_ = hb; unsigned char* const hb8_ = hb8; const float scale_ = scale; float* const ssq_ = ssq; const int pm_ = u.pm, pn_ = u.pn;
#pragma unroll
        for (int ai = 0; ai < 2; ++ai) {
            f32x4 bs[4][2][2];
#pragma unroll
            for (int m = 0; m < 4; ++m) { const size_t off = (size_t)(pm_ * BM + ai * HALF + wr * 64 + m * 16 + fr) * DM + pn_ * BM + wc * 32 + 4 * fq;
#pragma unroll
                for (int bj = 0; bj < 2; ++bj)
#pragma unroll
                    for (int n = 0; n < 2; ++n) { if constexpr (BASE_BF16) bs[m][bj][n] = bf4_to_f32(*(const u32x2*)(baseh_ + off + bj * HALF + n * 16)); else bs[m][bj][n] = *(const f32x4*)(basef_ + off + bj * HALF + n * 16); } }
#pragma unroll
            for (int m = 0; m < 4; ++m) {
                const int rl = ai * HALF + wr * 64 + m * 16 + fr, row = pm_ * BM + rl;
                float f = scale_; if constexpr (TWO_NORM) { float ra, rb; row_norms(row, ra, rb); f = rb; }
                const size_t off = (size_t)row * DM + pn_ * BM + wc * 32 + 4 * fq;
                float q = 0.f;
#pragma unroll
                for (int bj = 0; bj < 2; ++bj)
#pragma unroll
                    for (int n = 0; n < 2; ++n) { const f32x4 v = bs[m][bj][n] + acc[ai][bj][m][n] * f;
                        u32x2 w; w.x = cvt_pk_bf16(v[0], v[1]); w.y = cvt_pk_bf16(v[2], v[3]); *(u32x2*)(hb_ + off + bj * HALF + n * 16) = w;
                        if (hb8_) *(unsigned*)(hb8_ + off + bj * HALF + n * 16) = pk4_i8(v[0] * I8_X2_SCALE, v[1] * I8_X2_SCALE, v[2] * I8_X2_SCALE, v[3] * I8_X2_SCALE);
                        q += (v[0] * v[0] + v[1] * v[1]) + (v[2] * v[2] + v[3] * v[3]); }
                q += __shfl_xor(q, 16); q += __shfl_xor(q, 32);
                if (fq == 0) P[rl * 4 + wc] = q;
            }
            asm volatile("" ::: "memory");
        }
        asm volatile("s_waitcnt lgkmcnt(0)" ::: "memory"); __builtin_amdgcn_s_barrier(); asm volatile("" ::: "memory");
        const int tid = wid * 64 + lane;
        if (tid < 256) { const f32x4 pp = *(const PG8_LAS f32x4*)(P + tid * 4); ssq_[(size_t)(pm_ * BM + tid) * 8 + pn_] = (pp[0] + pp[1]) + (pp[2] + pp[3]); }
        asm volatile("s_waitcnt lgkmcnt(0)" ::: "memory"); __builtin_amdgcn_s_barrier(); asm volatile("" ::: "memory");
    }
};
struct EpiNull {
    static constexpr bool PERM = true, AFTER_DRAIN = false, MIDK = false;
    DI void operator()(const f32x4 (&acc)[2][2][4][2], const Unit& u, int wr, int wc, int fr, int fq) const {
#pragma unroll
        for (int ai = 0; ai < 2; ++ai)
#pragma unroll
            for (int bj = 0; bj < 2; ++bj)
#pragma unroll
                for (int m = 0; m < 4; ++m)
#pragma unroll
                    for (int n = 0; n < 2; ++n) asm volatile("" :: "v"(acc[ai][bj][m][n]));
    }
};
template <int NSS> DI float row_rs(const float* ss, int row, float invn) {
    float t = 0.f;
#pragma unroll
    for (int i = 0; i < NSS / 4; ++i) { const f32x4 q = *(const f32x4*)(ss + (size_t)row * NSS + 4 * i); t += (q[0] + q[1]) + (q[2] + q[3]); }
    return 1.0f / sqrtf(t * invn + EPS);
}
struct EpiBf16 {
    static constexpr bool PERM = true, AFTER_DRAIN = false, MIDK = false;
    bf16_t* O; int ldc; const float* ss;
    DI void operator()(const f32x4 (&acc)[2][2][4][2], const Unit& u, int wr, int wc, int fr, int fq) const {
#pragma unroll
        for (int ai = 0; ai < 2; ++ai)
#pragma unroll
            for (int m = 0; m < 4; ++m) {
                const int row = u.pm * BM + ai * HALF + wr * 64 + m * 16 + fr;
                const float rs = ss ? row_rs<12>(ss, row, 1.0f / 384.0f) : 1.0f;
                bf16_t* rowp = O + (size_t)row * ldc + u.pn * BM + wc * 32 + 8 * fq;
#pragma unroll
                for (int bj = 0; bj < 2; ++bj) { const f32x4 v0 = acc[ai][bj][m][0] * rs, v1 = acc[ai][bj][m][1] * rs;
                    u32x4 w; w.x = cvt_pk_bf16(v0[0], v0[1]); w.y = cvt_pk_bf16(v0[2], v0[3]); w.z = cvt_pk_bf16(v1[0], v1[1]); w.w = cvt_pk_bf16(v1[2], v1[3]);
                    *(u32x4*)(rowp + bj * HALF) = w; }
            }
    }
};
DI u32x4 pack8(const f32x4 a, const f32x4 b) { u32x4 w; w.x = cvt_pk_bf16(a[0], a[1]); w.y = cvt_pk_bf16(a[2], a[3]); w.z = cvt_pk_bf16(b[0], b[1]); w.w = cvt_pk_bf16(b[2], b[3]); return w; }
struct EpiProj {
    static constexpr bool PERM = true, AFTER_DRAIN = false, MIDK = false;
    unsigned char* ws; const float *qg, *kg; PG8_LAS float* P;
    DI void operator()(const f32x4 (&acc)[2][2][4][2], const Unit& u, int wr, int wc, int fr, int fq) const {
        const float* const ss = (const float*)(ws + WS_SS);
        bf16_t* const qn = (bf16_t*)(ws + WS_QN); bf16_t* const kcmp = (bf16_t*)(ws + WS_KCMP); bf16_t* const vcmp = (bf16_t*)(ws + WS_VCMP); bf16_t* const ks = (bf16_t*)(ws + WS_KS); bf16_t* const vs = (bf16_t*)(ws + WS_VS);
        bf16_t* const kw = (bf16_t*)(ws + WS_KW); bf16_t* const vw = (bf16_t*)(ws + WS_VW); bf16_t* const cq = (bf16_t*)(ws + WS_CQ); bf16_t* const ckv = (bf16_t*)(ws + WS_CKV);
        float* const krope = (float*)(ws + WS_KROPE); float* const gates = (float*)(ws + WS_GATES); float* const ssq_cq = (float*)(ws + WS_SSQCQ); float* const ssq_ckv = (float*)(ws + WS_SSQCKV);
        asm volatile("" : "+v"(fr), "+v"(fq));
        const int pn = u.pn, c8 = wc * 32 + 8 * fq;
        const bool norm2 = pn < 4 || pn == 6 || pn == 8;
        if (norm2) {
#pragma unroll
            for (int ai = 0; ai < 2; ++ai)
#pragma unroll
                for (int m = 0; m < 4; ++m) { const int rl = ai * HALF + wr * 64 + m * 16 + fr; const float rs = row_rs<8>(ss, u.pm * BM + rl, 1.0f / 2048.0f);
#pragma unroll
                    for (int bj = 0; bj < 2; ++bj) { const f32x4 a = acc[ai][bj][m][0] * rs, b = acc[ai][bj][m][1] * rs;
                        float q = ((a[0] * a[0] + a[1] * a[1]) + (a[2] * a[2] + a[3] * a[3])) + ((b[0] * b[0] + b[1] * b[1]) + (b[2] * b[2] + b[3] * b[3]));
                        q += __shfl_xor(q, 16); q += __shfl_xor(q, 32);
                        if (fq == 0) P[(rl * 2 + bj) * 4 + wc] = q; } }
            asm volatile("s_waitcnt lgkmcnt(0)" ::: "memory"); __builtin_amdgcn_s_barrier(); asm volatile("" ::: "memory");
            const float* gp = (pn < 4 ? qg : (pn == 6 ? kg + 128 : kg + 256)) + c8;
            const f32x4 g0 = *(const f32x4*)gp, g1 = *(const f32x4*)(gp + 4);
#pragma unroll
            for (int ai = 0; ai < 2; ++ai)
#pragma unroll
                for (int m = 0; m < 4; ++m) { const int rl = ai * HALF + wr * 64 + m * 16 + fr, row = u.pm * BM + rl, b = row >> 11, sq = row & 2047; const float rs = row_rs<8>(ss, row, 1.0f / 2048.0f);
#pragma unroll
                    for (int bj = 0; bj < 2; ++bj) { const f32x4 pp = *(const PG8_LAS f32x4*)(P + (rl * 2 + bj) * 4);
                        const float f = rs / sqrtf(((pp[0] + pp[1]) + (pp[2] + pp[3])) * (1.0f / 128.0f) + EPS);
                        const u32x4 w = pack8(acc[ai][bj][m][0] * f * g0, acc[ai][bj][m][1] * f * g1);
                        bf16_t* dst = pn < 4 ? qn + (size_t)row * 1024 + pn * 256 + bj * 128 + c8 : (pn == 6 ? ks : kw) + (((size_t)b * 2 + bj) * SEQ + sq) * 128 + c8;
                        *(u32x4*)dst = w; } }
            return;
        }
#pragma unroll
        for (int ai = 0; ai < 2; ++ai)
#pragma unroll
            for (int m = 0; m < 4; ++m) {
                const int row = u.pm * BM + ai * HALF + wr * 64 + m * 16 + fr, b = row >> 11, sq = row & 2047; const float rs = row_rs<8>(ss, row, 1.0f / 2048.0f);
#pragma unroll
                for (int bj = 0; bj < 2; ++bj) {
                    const f32x4 a = acc[ai][bj][m][0] * rs, c = acc[ai][bj][m][1] * rs;
                    if (pn == 4 || pn == 5) { *(u32x4*)((pn == 4 ? kcmp : vcmp) + (((size_t)bj * NB + b) * SEQ + sq) * 128 + c8) = pack8(a, c); }
                    else if (pn == 7 || pn == 9) { *(u32x4*)((pn == 7 ? vs : vw) + (((size_t)b * 2 + bj) * SEQ + sq) * 128 + c8) = pack8(a, c); }
                    else if (pn == 10 || (pn == 11 && bj == 0) || pn == 12) {
                        float q = ((a[0] * a[0] + a[1] * a[1]) + (a[2] * a[2] + a[3] * a[3])) + ((c[0] * c[0] + c[1] * c[1]) + (c[2] * c[2] + c[3] * c[3]));
                        q += __shfl_xor(q, 16); q += __shfl_xor(q, 32);
                        if (pn == 12) { *(u32x4*)(ckv + (size_t)row * 256 + bj * 128 + c8) = pack8(a, c); if (fq == 0) ssq_ckv[(size_t)row * 8 + bj * 4 + wc] = q; }
                        else { const int ch = (pn - 10) * 2 + bj; *(u32x4*)(cq + (size_t)row * 384 + ch * 128 + c8) = pack8(a, c); if (fq == 0) ssq_cq[(size_t)row * 12 + ch * 4 + wc] = q; }
                    } else {
                        float qk = ((a[0] * a[0] + a[1] * a[1]) + (a[2] * a[2] + a[3] * a[3])) + ((c[0] * c[0] + c[1] * c[1]) + (c[2] * c[2] + c[3] * c[3]));
                        qk += __shfl_xor(qk, 16); qk += __shfl_xor(qk, 32);
                        if (wc < 2) { *(f32x4*)(krope + (size_t)row * 64 + c8) = a; *(f32x4*)(krope + (size_t)row * 64 + c8 + 4) = c; if (fq == 0) ((float*)(ws + WS_SSQKR))[(size_t)row * 2 + wc] = qk; }
                        else if (wc == 2 && fq < 3) { f32x4 ga, gc;
#pragma unroll
                            for (int j = 0; j < 4; ++j) { ga[j] = 1.0f / (1.0f + __expf(-a[j])); gc[j] = 1.0f / (1.0f + __expf(-c[j])); }
                            *(f32x4*)(gates + (size_t)row * 24 + 8 * fq) = ga; *(f32x4*)(gates + (size_t)row * 24 + 8 * fq + 4) = gc; }
                    }
                }
            }
    }
};
struct EpiKV {
    static constexpr bool PERM = true, AFTER_DRAIN = false, MIDK = false;
    unsigned char* ws; const float* kgain; PG8_LAS float* P;
    DI void operator()(const f32x4 (&acc)[2][2][4][2], const Unit& u, int wr, int wc, int fr, int fq) const {
        const float* const ss = (const float*)(ws + WS_SSQCKV); const float* const ssk = (const float*)(ws + WS_SSQKR);
        bf16_t* const km = (bf16_t*)(ws + WS_KM); bf16_t* const vm = (bf16_t*)(ws + WS_VM);
        PG8_LAS float* const Rt = P + 1024;
        asm volatile("" : "+v"(fr), "+v"(fq));
        const int h = u.pn, c8 = wc * 32 + 8 * fq;
#pragma unroll
        for (int ai = 0; ai < 2; ++ai)
#pragma unroll
            for (int m = 0; m < 4; ++m) { const int rl = ai * HALF + wr * 64 + m * 16 + fr; const float rs = row_rs<8>(ss, u.pm * BM + rl, 1.0f / 256.0f);
                const f32x4 a = acc[ai][0][m][0] * rs, b = acc[ai][0][m][1] * rs;
                float q = ((a[0] * a[0] + a[1] * a[1]) + (a[2] * a[2] + a[3] * a[3])) + ((b[0] * b[0] + b[1] * b[1]) + (b[2] * b[2] + b[3] * b[3]));
                q += __shfl_xor(q, 16); q += __shfl_xor(q, 32);
                if (fq == 0) P[rl * 4 + wc] = q; }
        asm volatile("s_waitcnt lgkmcnt(0)" ::: "memory"); __builtin_amdgcn_s_barrier(); asm volatile("" ::: "memory");
        const f32x4 g0 = *(const f32x4*)(kgain + c8), g1 = *(const f32x4*)(kgain + c8 + 4);
#pragma unroll
        for (int ai = 0; ai < 2; ++ai)
#pragma unroll
            for (int m = 0; m < 4; ++m) { const int rl = ai * HALF + wr * 64 + m * 16 + fr, row = u.pm * BM + rl, b = row >> 11, sq = row & 2047; const float rs = row_rs<8>(ss, row, 1.0f / 256.0f);
                const f32x4 pp = *(const PG8_LAS f32x4*)(P + rl * 4); const f32x2 kk = *(const f32x2*)(ssk + (size_t)row * 2);
                const float rh = 1.0f / sqrtf((((pp[0] + pp[1]) + (pp[2] + pp[3])) + (kk.x + kk.y)) * (1.0f / 192.0f) + EPS);
                if (wc == 0 && fq == 0) Rt[rl] = rh;
                const float f = rs * rh;
                *(u32x4*)(km + (((size_t)b * 8 + h) * SEQ + sq) * 192 + c8) = pack8(acc[ai][0][m][0] * f * g0, acc[ai][0][m][1] * f * g1);
                *(u32x4*)(vm + (((size_t)b * 8 + h) * SEQ + sq) * 128 + c8) = pack8(acc[ai][1][m][0] * rs, acc[ai][1][m][1] * rs);
                asm volatile("" ::: "memory"); }
        asm volatile("s_waitcnt lgkmcnt(0)" ::: "memory"); __builtin_amdgcn_s_barrier(); asm volatile("" ::: "memory");
        {
            const int tid = (wr * 4 + wc) * 64 + fq * 16 + fr, rl2 = tid >> 1, i0 = (tid & 1) * 16, row = u.pm * BM + rl2, b = row >> 11, sq = row & 2047;
            const float rh = Rt[rl2];
            const float* kr = (const float*)(ws + WS_KROPE) + (size_t)row * 64; const float* rp = (const float*)(ws + WS_ROPE) + ((size_t)sq * 32 + i0) * 2;
            bf16_t* ko = km + (((size_t)b * 8 + h) * SEQ + sq) * 192 + 128;
            u32x4 w1[2], w2[2];
#pragma unroll
            for (int v4 = 0; v4 < 2; ++v4) {
                float o1[8], o2[8];
#pragma unroll
                for (int e = 0; e < 2; ++e) { const int i = i0 + 8 * v4 + 4 * e;
                    const f32x4 x1 = *(const f32x4*)(kr + i), x2 = *(const f32x4*)(kr + 32 + i), ga = *(const f32x4*)(kgain + 128 + i), gb = *(const f32x4*)(kgain + 160 + i);
                    const f32x4 cs0 = *(const f32x4*)(rp + (8 * v4 + 4 * e) * 2), cs1 = *(const f32x4*)(rp + (8 * v4 + 4 * e) * 2 + 4);
#pragma unroll
                    for (int j = 0; j < 4; ++j) { const float a = x1[j] * rh * ga[j], c = x2[j] * rh * gb[j]; const float co = j < 2 ? cs0[2 * j] : cs1[2 * (j - 2)], si = j < 2 ? cs0[2 * j + 1] : cs1[2 * (j - 2) + 1];
                        o1[4 * e + j] = a * co - c * si; o2[4 * e + j] = c * co + a * si; } }
                w1[v4].x = cvt_pk_bf16(o1[0], o1[1]); w1[v4].y = cvt_pk_bf16(o1[2], o1[3]); w1[v4].z = cvt_pk_bf16(o1[4], o1[5]); w1[v4].w = cvt_pk_bf16(o1[6], o1[7]);
                w2[v4].x = cvt_pk_bf16(o2[0], o2[1]); w2[v4].y = cvt_pk_bf16(o2[2], o2[3]); w2[v4].z = cvt_pk_bf16(o2[4], o2[5]); w2[v4].w = cvt_pk_bf16(o2[6], o2[7]);
            }
            *(u32x4*)(ko + i0) = w1[0]; *(u32x4*)(ko + i0 + 8) = w1[1]; *(u32x4*)(ko + 32 + i0) = w2[0]; *(u32x4*)(ko + 32 + i0 + 8) = w2[1];
        }
    }
};
struct EpiSlab {
    static constexpr bool PERM = false, AFTER_DRAIN = false, MIDK = false;
    float* slab;
    DI void operator()(const f32x4 (&acc)[2][2][4][2], const Unit& u, int wr, int wc, int fr, int fq) const {
        float* s = slab + (size_t)u.aux * 512 * 256;
#pragma unroll
        for (int ai = 0; ai < 2; ++ai)
#pragma unroll
            for (int m = 0; m < 4; ++m) {
                float* rowp = s + (size_t)(u.pm * BM + ai * HALF + wr * 64 + m * 16 + fr) * 256 + wc * 32 + 4 * fq;
#pragma unroll
                for (int bj = 0; bj < 2; ++bj)
#pragma unroll
                    for (int n = 0; n < 2; ++n) *(f32x4*)(rowp + bj * HALF + n * 16) = acc[ai][bj][m][n];
            }
    }
};

struct EpiP6 {
    static constexpr bool PERM = true, AFTER_DRAIN = false, MIDK = false;
    EpiBf16 eq; EpiKV ekv; EpiSlab es;
    DI void operator()(const f32x4 (&acc)[2][2][4][2], const Unit& u, int wr, int wc, int fr, int fq) const {
        if (u.type == 0) eq(acc, u, wr, wc, fr, fq); else if (u.type == 1) ekv(acc, u, wr, wc, fr, fq); else es(acc, u, wr, wc, fr, fq);
    }
};
template <class Epi, class Sched, bool ALIGN_EPI, bool MULTI = false, int DBG = 0, int QM = 0>
DI void gemm_phase(PG8_LAS unsigned char* lds, const Gemm g, const Sched& S, const Epi& E) {
    constexpr bool F8 = (QM == 1);
    int tid = threadIdx.x; asm volatile("" : "+v"(tid));
    const int wid = __builtin_amdgcn_readfirstlane(tid >> 6), lane = tid & 63, wr = wid >> 2, wc = wid & 3, fr = lane & 15, fq = lane >> 4;
    int K = g.K; asm volatile("" : "+s"(K)); int nt = K / BK;
    unsigned voffA[2], voffB[2];
#pragma unroll
    for (int i = 0; i < 2; ++i) { int R, C; stage_rc(tid * 16 + i * 8192, R, C); const int Rb = Epi::PERM ? ((R & ~31) + perm32(R & 31)) : R;
        voffA[i] = (unsigned)(R * g.lda + C) * 2u; voffB[i] = (unsigned)(Rb * g.ldb + C) * 2u; }
    const size_t kstep = (size_t)(BK * 2);
    size_t hstepA = (size_t)HALF * g.lda * 2, hstepB = (size_t)HALF * g.ldb * 2;
#define PG8_GEOM(u_, va_, vb_, ha_, hb_) do { const int la_ = mg_lda((u_).type), lb_ = mg_ldb((u_).type), pe_ = mg_perm((u_).type); _Pragma("unroll") for (int i_ = 0; i_ < 2; ++i_) { int R_, C_; stage_rc(tid * 16 + i_ * 8192, R_, C_); const int Rb_ = pe_ ? ((R_ & ~31) + perm32(R_ & 31)) : R_; \
        va_[i_] = (unsigned)(R_ * la_ + C_ * 2); vb_[i_] = (unsigned)(Rb_ * lb_ + C_ * 2); } ha_ = (size_t)HALF * la_; hb_ = (size_t)HALF * lb_; } while (0)
    const unsigned ldsw = (unsigned)wid * 1024u;
    const int aoff = lds_byte(wr * 64 + fr, fq * 8), boff = lds_byte(wc * 32 + fr, fq * 8);
#define PG8_SA(b, h) (((b) * 2 + (h)) * HTB)
#define PG8_SB(b, h) ((4 + (b) * 2 + (h)) * HTB)
#define PG8_STAGE(bufoff, gbase, voff) do { if constexpr (DBG != 2) _Pragma("unroll") for (int _i = 0; _i < 2; ++_i) { unsigned vo_ = (voff)[_i]; asm volatile("" : "+v"(vo_)); \
        __builtin_amdgcn_global_load_lds((const unsigned*)((const char*)(gbase) + vo_), (PG8_LAS unsigned*)(lds + (bufoff) + ldsw + _i * 8192), 16, 0, 0); } } while (0)
#define PG8_LDA(dst, b, h) do { _Pragma("unroll") for (int m = 0; m < 4; ++m) _Pragma("unroll") for (int k = 0; k < 2; ++k) dst[m][k] = *(const PG8_LAS bf16x8*)(lds + PG8_SA(b, h) + aoff + m * 2048 + k * 1024); } while (0)
#define PG8_LDB(dst, b, h) do { _Pragma("unroll") for (int n = 0; n < 2; ++n) _Pragma("unroll") for (int k = 0; k < 2; ++k) dst[n][k] = *(const PG8_LAS bf16x8*)(lds + PG8_SB(b, h) + boff + n * 2048 + k * 1024); } while (0)
#define PG8_MMA(ai, bj, At, Bt) do { __builtin_amdgcn_s_setprio(1); if constexpr (DBG == 1) { _Pragma("unroll") for (int m = 0; m < 4; ++m) _Pragma("unroll") for (int k = 0; k < 2; ++k) asm volatile("" :: "v"(At[m][k])); _Pragma("unroll") for (int n = 0; n < 2; ++n) _Pragma("unroll") for (int k = 0; k < 2; ++k) asm volatile("" :: "v"(Bt[n][k])); } \
        if constexpr (DBG != 1 && F8) _Pragma("unroll") for (int m = 0; m < 4; ++m) _Pragma("unroll") for (int n = 0; n < 2; ++n) \
        acc[ai][bj][m][n] = __builtin_amdgcn_mfma_scale_f32_16x16x128_f8f6f4(f8cat(Bt[n][0], Bt[n][1]), f8cat(At[m][0], At[m][1]), acc[ai][bj][m][n], 0, 0, 0, 0, 0, 0); \
        if constexpr (DBG != 1 && QM == 2) _Pragma("unroll") for (int m = 0; m < 4; ++m) _Pragma("unroll") for (int n = 0; n < 2; ++n) _Pragma("unroll") for (int k = 0; k < 2; ++k) \
        acc[ai][bj][m][n] = __builtin_bit_cast(f32x4, __builtin_amdgcn_mfma_i32_16x16x64_i8(__builtin_bit_cast(i32x4v, Bt[n][k]), __builtin_bit_cast(i32x4v, At[m][k]), __builtin_bit_cast(i32x4v, acc[ai][bj][m][n]), 0, 0, 0)); \
        if constexpr (DBG != 1 && QM == 0) _Pragma("unroll") for (int m = 0; m < 4; ++m) _Pragma("unroll") for (int n = 0; n < 2; ++n) _Pragma("unroll") for (int k = 0; k < 2; ++k) \
        acc[ai][bj][m][n] = __builtin_amdgcn_mfma_f32_16x16x32_bf16(Bt[n][k], At[m][k], acc[ai][bj][m][n], 0, 0, 0); __builtin_amdgcn_s_setprio(0); } while (0)
#define PG8_WAIT_V(n) asm volatile("s_waitcnt vmcnt(" #n ")" ::: "memory")
#define PG8_WAIT_L(n) asm volatile("s_waitcnt lgkmcnt(" #n ")" ::: "memory")
#define PG8_BAR __builtin_amdgcn_s_barrier()
#define PG8_SCHED __builtin_amdgcn_sched_barrier(0)
    Unit cur, nxt; int ui = 0;
    if (!S.next(0, cur)) return;
    f32x4 acc[2][2][4][2];
#pragma unroll
    for (int a = 0; a < 2; ++a)
#pragma unroll
        for (int b = 0; b < 2; ++b)
#pragma unroll
            for (int m = 0; m < 4; ++m)
#pragma unroll
                for (int n = 0; n < 2; ++n) acc[a][b][m][n] = (f32x4){0.f, 0.f, 0.f, 0.f};
    bf16x8 At[4][2], B0[2][2], B1[2][2];
    const char* cA = cur.A; const char* cB = cur.B;
    if constexpr (MULTI) { PG8_GEOM(cur, voffA, voffB, hstepA, hstepB); nt = mg_nt(cur.type); }
#if PG8_SP2 == 2
    PG8_STAGE(PG8_SB(0, 0), cB, voffB); PG8_STAGE(PG8_SB(0, 1), cB + hstepB, voffB); PG8_STAGE(PG8_SA(0, 0), cA, voffA); PG8_STAGE(PG8_SA(0, 1), cA + hstepA, voffA);
    PG8_STAGE(PG8_SB(1, 0), cB + kstep, voffB); PG8_STAGE(PG8_SB(1, 1), cB + hstepB + kstep, voffB);
    if (wr == 1) PG8_BAR;
    PG8_WAIT_V(6); PG8_BAR; PG8_BAR;
#elif PG8_SP2
    PG8_STAGE(PG8_SB(0, 0), cB, voffB); PG8_STAGE(PG8_SB(0, 1), cB + hstepB, voffB); PG8_STAGE(PG8_SA(0, 0), cA, voffA); PG8_STAGE(PG8_SA(0, 1), cA + hstepA, voffA);
    if (wr == 1) PG8_BAR;
    PG8_WAIT_V(2); PG8_BAR;
#else
    PG8_STAGE(PG8_SB(0, 0), cB, voffB); PG8_STAGE(PG8_SA(0, 0), cA, voffA); PG8_STAGE(PG8_SB(0, 1), cB + hstepB, voffB); PG8_STAGE(PG8_SA(0, 1), cA + hstepA, voffA);
    if (wr == 1) PG8_BAR;
    PG8_WAIT_V(4); PG8_BAR;
#endif
#if PG8_SP2 != 2
    PG8_STAGE(PG8_SB(1, 0), cB + kstep, voffB); PG8_STAGE(PG8_SA(1, 0), cA + kstep, voffA); PG8_STAGE(PG8_SB(1, 1), cB + hstepB + kstep, voffB);
    PG8_WAIT_V(6); PG8_BAR;
#endif
    for (;;) {
        const bool has_next = S.next(ui + 1, nxt);
        const char* nA = has_next ? nxt.A : cA; const char* nB = has_next ? nxt.B : cB;
#pragma unroll 1
        for (int t = 0; t < nt; t += 2) {
            const bool last = (t == nt - 2);
            const char* a1 = cA + (size_t)(t + 1) * kstep;
            const char* a2 = last ? nA : cA + (size_t)(t + 2) * kstep; const char* b2 = last ? nB : cB + (size_t)(t + 2) * kstep;
            const char* a3 = a2 + kstep; const char* b3 = b2 + kstep;
            unsigned svA[2], svB[2]; size_t shA, shB;
            svA[0] = voffA[0]; svA[1] = voffA[1]; svB[0] = voffB[0]; svB[1] = voffB[1]; shA = hstepA; shB = hstepB;
            if constexpr (MULTI) { if (last && has_next) PG8_GEOM(nxt, svA, svB, shA, shB); }
            if constexpr (Epi::MIDK) { if (t == (nt >> 1)) E.midk(acc, cur, wr, wc, fr, fq); }
#if PG8_SP2 == 2
            PG8_LDB(B0, 0, 0); PG8_LDB(B1, 0, 1); PG8_SCHED; PG8_LDA(At, 0, 0); PG8_STAGE(PG8_SA(1, 0), a1, voffA); PG8_STAGE(PG8_SA(1, 1), a1 + hstepA, voffA);
            PG8_WAIT_V(8); PG8_WAIT_L(0); PG8_BAR; PG8_MMA(0, 0, At, B0); PG8_MMA(0, 1, At, B1); PG8_BAR; PG8_SCHED;
            PG8_LDA(At, 0, 1); PG8_STAGE(PG8_SB(0, 0), b2, svB); PG8_STAGE(PG8_SB(0, 1), b2 + shB, svB);
            PG8_WAIT_V(6); PG8_WAIT_L(0); PG8_BAR; PG8_MMA(1, 0, At, B0); PG8_MMA(1, 1, At, B1); PG8_BAR; PG8_SCHED;
            PG8_LDB(B0, 1, 0); PG8_LDB(B1, 1, 1); PG8_SCHED; PG8_LDA(At, 1, 0); PG8_STAGE(PG8_SA(0, 0), a2, svA); PG8_STAGE(PG8_SA(0, 1), a2 + shA, svA);
            PG8_WAIT_V(8); PG8_WAIT_L(0); PG8_BAR; PG8_MMA(0, 0, At, B0); PG8_MMA(0, 1, At, B1); PG8_BAR; PG8_SCHED;
            PG8_LDA(At, 1, 1); PG8_STAGE(PG8_SB(1, 0), b3, svB); PG8_STAGE(PG8_SB(1, 1), b3 + shB, svB);
            PG8_WAIT_V(6); PG8_WAIT_L(0); PG8_BAR; PG8_MMA(1, 0, At, B0); PG8_MMA(1, 1, At, B1); PG8_BAR; PG8_SCHED;
#elif PG8_SP2
            PG8_LDB(B0, 0, 0); PG8_LDB(B1, 0, 1); PG8_SCHED; PG8_LDA(At, 0, 0); PG8_STAGE(PG8_SA(1, 1), a1 + hstepA, voffA);
            PG8_WAIT_V(8); PG8_WAIT_L(0); PG8_BAR; PG8_MMA(0, 0, At, B0); PG8_MMA(0, 1, At, B1); PG8_BAR; PG8_SCHED;
            PG8_LDA(At, 0, 1); PG8_STAGE(PG8_SB(0, 0), b2, svB); PG8_STAGE(PG8_SB(0, 1), b2 + shB, svB); PG8_STAGE(PG8_SA(0, 0), a2, svA);
            PG8_WAIT_V(8); PG8_WAIT_L(0); PG8_BAR; PG8_MMA(1, 0, At, B0); PG8_MMA(1, 1, At, B1); PG8_BAR; PG8_SCHED;
            PG8_LDB(B0, 1, 0); PG8_LDB(B1, 1, 1); PG8_SCHED; PG8_LDA(At, 1, 0); PG8_STAGE(PG8_SA(0, 1), a2 + shA, svA);
            PG8_WAIT_V(8); PG8_WAIT_L(0); PG8_BAR; PG8_MMA(0, 0, At, B0); PG8_MMA(0, 1, At, B1); PG8_BAR; PG8_SCHED;
            PG8_LDA(At, 1, 1); PG8_STAGE(PG8_SB(1, 0), b3, svB); PG8_STAGE(PG8_SB(1, 1), b3 + shB, svB); PG8_STAGE(PG8_SA(1, 0), a3, svA);
            PG8_WAIT_V(8); PG8_WAIT_L(0); PG8_BAR; PG8_MMA(1, 0, At, B0); PG8_MMA(1, 1, At, B1); PG8_BAR; PG8_SCHED;
#else
            PG8_LDB(B0, 0, 0); PG8_SCHED; PG8_LDA(At, 0, 0); PG8_STAGE(PG8_SA(1, 1), a1 + hstepA, voffA);
            PG8_WAIT_L(8); PG8_BAR; PG8_WAIT_L(0); PG8_MMA(0, 0, At, B0); PG8_BAR; PG8_SCHED;
            PG8_LDB(B1, 0, 1); PG8_STAGE(PG8_SB(0, 0), b2, voffB);
            PG8_BAR; PG8_WAIT_L(0); PG8_MMA(0, 1, At, B1); PG8_BAR;
            PG8_LDA(At, 0, 1); PG8_STAGE(PG8_SA(0, 0), a2, voffA);
            PG8_BAR; PG8_WAIT_L(0); PG8_MMA(1, 0, At, B0); PG8_BAR; PG8_SCHED;
            PG8_STAGE(PG8_SB(0, 1), b2 + hstepB, voffB);
            PG8_WAIT_V(6); PG8_BAR; PG8_MMA(1, 1, At, B1); PG8_BAR;
            PG8_LDB(B0, 1, 0); PG8_SCHED; PG8_LDA(At, 1, 0); PG8_STAGE(PG8_SA(0, 1), a2 + hstepA, voffA);
            PG8_WAIT_L(8); PG8_BAR; PG8_WAIT_L(0); PG8_MMA(0, 0, At, B0); PG8_BAR; PG8_SCHED;
            PG8_LDB(B1, 1, 1); PG8_STAGE(PG8_SB(1, 0), b3, voffB);
            PG8_BAR; PG8_WAIT_L(0); PG8_MMA(0, 1, At, B1); PG8_BAR;
            PG8_LDA(At, 1, 1); PG8_STAGE(PG8_SA(1, 0), a3, voffA);
            PG8_BAR; PG8_WAIT_L(0); PG8_MMA(1, 0, At, B0); PG8_BAR; PG8_SCHED;
            PG8_STAGE(PG8_SB(1, 1), b3 + hstepB, voffB);
            PG8_WAIT_V(6); PG8_BAR; PG8_MMA(1, 1, At, B1); PG8_BAR;
#endif
        }
        if constexpr (ALIGN_EPI) { if (wr == 0) PG8_BAR; }
        if constexpr (!Epi::AFTER_DRAIN) { if constexpr (F8) { int t3; asm volatile("v_mbcnt_lo_u32_b32 %0, -1, 0\n\tv_mbcnt_hi_u32_b32 %0, -1, %0" : "=v"(t3)); E(acc, cur, wr, wc, t3 & 15, t3 >> 4); }
            else E(acc, cur, wr, wc, fr, fq); }
        if (!has_next) break;
#pragma unroll
        for (int a = 0; a < 2; ++a)
#pragma unroll
            for (int b = 0; b < 2; ++b)
#pragma unroll
                for (int m = 0; m < 4; ++m)
#pragma unroll
                    for (int n = 0; n < 2; ++n) acc[a][b][m][n] = (f32x4){0.f, 0.f, 0.f, 0.f};
        cur = nxt; cA = nA; cB = nB; ++ui;
        if constexpr (MULTI) { PG8_GEOM(cur, voffA, voffB, hstepA, hstepB); nt = mg_nt(cur.type); }
        if constexpr (ALIGN_EPI) { if (wr == 1) PG8_BAR; }
    }
    PG8_WAIT_V(0);
    if constexpr (!ALIGN_EPI) { if (wr == 0) PG8_BAR; }
    PG8_BAR;
    if constexpr (Epi::AFTER_DRAIN) E.fused(acc, cur, wr, wc, fr, fq, lds, wid, lane);
#undef PG8_GEOM
#undef PG8_SA
#undef PG8_SB
#undef PG8_STAGE
#undef PG8_LDA
#undef PG8_LDB
#undef PG8_MMA
#undef PG8_WAIT_V
#undef PG8_WAIT_L
#undef PG8_BAR
#undef PG8_SCHED
}
}

namespace att {
typedef float f32x16 __attribute__((ext_vector_type(16)));
typedef short s16x4 __attribute__((ext_vector_type(4)));
#define KSWZ(row, colB) ((row) * 256 + ((colB) ^ (((row) & 7) << 4)))
#define SBAR() __builtin_amdgcn_sched_barrier(0)
constexpr int L_V = 0, L_K = 16384, L_KR = 32768, L_WS = 40960, L_MAIN = 43008, L_LAST = L_MAIN + 33792, L_IMP = L_LAST + 33792, L_SELB = L_IMP + 8448, L_ANY = L_SELB + 512, L_END = L_ANY + 16;
static_assert(L_END <= LDS_BYTES, "attention LDS map");
DI int v_st(int k, int c) { const int kk = (k & ~0xC) | ((k & 4) << 1) | ((k & 8) >> 1); return ((kk >> 3) * 4 + (c >> 5)) * 512 + ((kk & 7) * 32 + (c & 31)) * 2; }
DI int v_rd_base(int lane) { return ((lane & 3) << 3) | (((lane >> 2) & 3) << 6) | (((lane >> 4) & 1) << 5) | (((lane >> 5) & 1) << 8); }
constexpr int v_rd_off(int d0, int ks, int half) { return d0 * 512 + ks * 4096 + half * 2048; }
DI int crow(int r, int hi) { return (r & 3) + 8 * (r >> 2) + 4 * hi; }
DI unsigned cvtpk(float lo, float hi) { unsigned r; asm volatile("v_cvt_pk_bf16_f32 %0, %1, %2" : "=v"(r) : "v"(lo), "v"(hi)); return r; }

DI void mask_range(f32x16& p0, f32x16& p1, int lo, int hiB) {
    const float NEG = -__builtin_inff(); const unsigned w = hiB > lo ? (unsigned)(hiB - lo) : 0u;
#pragma unroll
    for (int r = 0; r < 16; ++r) { const int c = (r & 3) + 8 * (r >> 2);
        if ((unsigned)(c - lo) >= w) p0[r] = NEG;
        if ((unsigned)(c + 32 - lo) >= w) p1[r] = NEG; }
}
DI void softmax_tile(f32x16& p0, f32x16& p1, float& m, float& l, float c1, float& alpha) {
    float pmax = p0[0];
#pragma unroll
    for (int r = 1; r < 16; ++r) pmax = fmaxf(pmax, p0[r]);
#pragma unroll
    for (int r = 0; r < 16; ++r) pmax = fmaxf(pmax, p1[r]);
    { auto rr = __builtin_amdgcn_permlane32_swap(__float_as_uint(pmax), __float_as_uint(pmax), false, false); pmax = fmaxf(__uint_as_float(rr[0]), __uint_as_float(rr[1])); }
    float mn;
    if (__all((pmax - m) * c1 <= 8.0f)) { mn = m; alpha = 1.0f; }
    else { mn = fmaxf(m, pmax); alpha = __builtin_amdgcn_exp2f((m - mn) * c1); m = mn; }
    const float mnL = -mn * c1;
#pragma unroll
    for (int r = 0; r < 16; ++r) p0[r] = __builtin_amdgcn_exp2f(fmaf(p0[r], c1, mnL));
#pragma unroll
    for (int r = 0; r < 16; ++r) p1[r] = __builtin_amdgcn_exp2f(fmaf(p1[r], c1, mnL));
    float ps = 0.f;
#pragma unroll
    for (int r = 0; r < 16; ++r) ps += p0[r];
#pragma unroll
    for (int r = 0; r < 16; ++r) ps += p1[r];
    { auto rr = __builtin_amdgcn_permlane32_swap(__float_as_uint(ps), __float_as_uint(ps), false, false); ps = __uint_as_float(rr[0]) + __uint_as_float(rr[1]); }
    l = l * alpha + ps;
}
DI void pack_p(const f32x16& p0, const f32x16& p1, bf16x8& pa0, bf16x8& pa1, bf16x8& pa2, bf16x8& pa3) {
#define PK4(P, B_, OUT) do { unsigned a0 = cvtpk(P[B_+0], P[B_+1]), a1 = cvtpk(P[B_+2], P[B_+3]); unsigned b0 = cvtpk(P[B_+4], P[B_+5]), b1 = cvtpk(P[B_+6], P[B_+7]); \
        auto r0 = __builtin_amdgcn_permlane32_swap(a0, b0, false, false); auto r1 = __builtin_amdgcn_permlane32_swap(a1, b1, false, false); \
        u32x4 w = {r0[0], r1[0], r0[1], r1[1]}; OUT = *reinterpret_cast<bf16x8*>(&w); } while (0)
    PK4(p0, 0, pa0); PK4(p0, 8, pa1); PK4(p1, 0, pa2); PK4(p1, 8, pa3);
#undef PK4
}
DI void qkt128(f32x16& p0, f32x16& p1, const char* K_lds, int r32, int hi, const bf16x8* qr) {
    const char* kb[4];
#pragma unroll
    for (int dd = 0; dd < 4; ++dd) kb[dd] = K_lds + KSWZ(r32, (dd * 16 + hi * 8) * 2);
#pragma unroll
    for (int d0 = 0; d0 < 8; ++d0) { const char* a = kb[d0 & 3] + (d0 >> 2) * 128;
        const bf16x8 b0 = *reinterpret_cast<const bf16x8*>(a);
        const bf16x8 b1 = *reinterpret_cast<const bf16x8*>(a + 32 * 256);
        p0 = __builtin_amdgcn_mfma_f32_32x32x16_bf16(b0, qr[d0], p0, 0, 0, 0);
        p1 = __builtin_amdgcn_mfma_f32_32x32x16_bf16(b1, qr[d0], p1, 0, 0, 0); }
}
DI void qkt_rope(f32x16& p0, f32x16& p1, const char* KR_lds, int r32, int hi, const bf16x8* qr8) {
#pragma unroll
    for (int d0 = 0; d0 < 4; ++d0) { const char* a = KR_lds + r32 * 128 + (((2 * d0 + hi) ^ ((r32 >> 1) & 7)) << 4);
        const bf16x8 b0 = *reinterpret_cast<const bf16x8*>(a);
        const bf16x8 b1 = *reinterpret_cast<const bf16x8*>(a + 32 * 128);
        p0 = __builtin_amdgcn_mfma_f32_32x32x16_bf16(b0, qr8[d0], p0, 0, 0, 0);
        p1 = __builtin_amdgcn_mfma_f32_32x32x16_bf16(b1, qr8[d0], p1, 0, 0, 0); }
}
DI void pv_tile(f32x16* o, int vb0, bf16x8 pa0, bf16x8 pa1, bf16x8 pa2, bf16x8 pa3) {
#define TRRD(dst, off) asm volatile("ds_read_b64_tr_b16 %0, %1 offset:%2" : "=&v"(dst) : "v"(vb0), "i"(off) : "memory")
#define PV_D0(d0) do { s16x4 l0, l1, l2, l3, h0, h1, h2, h3; constexpr int b_ = v_rd_off(d0, 0, 0); \
        TRRD(l0, b_); TRRD(h0, b_ + 2048); TRRD(l1, b_ + 4096); TRRD(h1, b_ + 6144); TRRD(l2, b_ + 8192); TRRD(h2, b_ + 10240); TRRD(l3, b_ + 12288); TRRD(h3, b_ + 14336); \
        asm volatile("s_waitcnt lgkmcnt(0)" ::: "memory"); SBAR(); \
        o[d0] = __builtin_amdgcn_mfma_f32_32x32x16_bf16(pa0, (bf16x8){l0[0], l0[1], l0[2], l0[3], h0[0], h0[1], h0[2], h0[3]}, o[d0], 0, 0, 0); \
        o[d0] = __builtin_amdgcn_mfma_f32_32x32x16_bf16(pa1, (bf16x8){l1[0], l1[1], l1[2], l1[3], h1[0], h1[1], h1[2], h1[3]}, o[d0], 0, 0, 0); \
        o[d0] = __builtin_amdgcn_mfma_f32_32x32x16_bf16(pa2, (bf16x8){l2[0], l2[1], l2[2], l2[3], h2[0], h2[1], h2[2], h2[3]}, o[d0], 0, 0, 0); \
        o[d0] = __builtin_amdgcn_mfma_f32_32x32x16_bf16(pa3, (bf16x8){l3[0], l3[1], l3[2], l3[3], h3[0], h3[1], h3[2], h3[3]}, o[d0], 0, 0, 0); } while (0)
    PV_D0(0); PV_D0(1); PV_D0(2); PV_D0(3);
#undef PV_D0
#undef TRRD
}
DI void scale_rows(f32x16* o, float f, float* al_l, int r32, int hi) {
    if (hi == 0) al_l[r32] = f;
    asm volatile("s_waitcnt lgkmcnt(0)" ::: "memory");
#pragma unroll
    for (int r = 0; r < 16; ++r) { const float a = al_l[crow(r, hi)];
#pragma unroll
        for (int d = 0; d < 4; ++d) o[d][r] *= a; }
    asm volatile("s_waitcnt lgkmcnt(0)" ::: "memory");
}
DI void tile128(f32x16& p0, f32x16& p1, f32x16* o, float& m, float& l, float c1, const char* K_lds, int vb0, const bf16x8* qr, bool needm, int lo, int hiB, float* al_l, int r32, int hi) {
    qkt128(p0, p1, K_lds, r32, hi, qr);
    if (needm) mask_range(p0, p1, lo, hiB);
    float alpha; softmax_tile(p0, p1, m, l, c1, alpha);
    if (__any(alpha < 1.f)) scale_rows(o, alpha, al_l, r32, hi);
    bf16x8 pa0, pa1, pa2, pa3; pack_p(p0, p1, pa0, pa1, pa2, pa3); SBAR();
    pv_tile(o, vb0, pa0, pa1, pa2, pa3);
}
DI void bias_init(f32x16& p0, f32x16& p1, float b0, float step) {
#pragma unroll
    for (int r = 0; r < 16; ++r) { const float c = (float)((r & 3) + 8 * (r >> 2)); p0[r] = fmaf(step, c, b0); p1[r] = fmaf(step, c + 32.f, b0); }
}

template <int PART>
DI void nsa_unit(char* lds, int b, int g, int qt, unsigned char* ws) {
    const bf16_t* const QN = (const bf16_t*)(ws + WS_QN); const bf16_t* const KC = (const bf16_t*)(ws + WS_KC); const bf16_t* const VC = (const bf16_t*)(ws + WS_VC);
    const bf16_t* const KS = (const bf16_t*)(ws + WS_KS); const bf16_t* const VS = (const bf16_t*)(ws + WS_VS); const bf16_t* const KW = (const bf16_t*)(ws + WS_KW); const bf16_t* const VW = (const bf16_t*)(ws + WS_VW);
    const float* const GATES = (const float*)(ws + WS_GATES); float* const OTMP = (float*)(ws + WS_SLAB); float* const SSO = (float*)(ws + WS_SSO); bf16_t* const Hout = (bf16_t*)(ws + WS_H);
    int tid = threadIdx.x; asm volatile("" : "+v"(tid));
    const int wid = __builtin_amdgcn_readfirstlane(tid >> 6), lane = tid & 63, r32 = lane & 31, hi = lane >> 5;
    const int hr = wid & 3, th = wid >> 2, h = g * 4 + hr, q0 = qt * 64, tok = th * 32 + r32, t = q0 + tok;
    const size_t row = (size_t)b * SEQ + t;
    char* V_lds = lds + L_V; char* K_lds = lds + L_K; float* al_l = (float*)(lds + L_WS) + wid * 64;
    float* MAIN = (float*)(lds + L_MAIN); float* LAST = (float*)(lds + L_LAST); float* IMP = (float*)(lds + L_IMP);
    unsigned char* SELB = (unsigned char*)(lds + L_SELB); unsigned* ANY = (unsigned*)(lds + L_ANY);
    const int sr = tid >> 4, sc = (tid & 15) * 8, kws = KSWZ(sr, sc * 2), vst0 = v_st(sr, sc), vst1 = v_st(32 + sr, sc);
    const int vb0 = (int)(uintptr_t)V_lds + v_rd_base(lane);
    bf16x8 qr[8];
#pragma unroll
    for (int d0 = 0; d0 < 8; ++d0) qr[d0] = *(const bf16x8*)(QN + row * 1024 + h * 128 + d0 * 16 + hi * 8);
    const float c1 = 0.08838834764831845f * 1.4426950408889634f;
    const float cs = exp2f(-(float)(h + 1)) * 1.4426950408889634f / c1;
    bf16x8 st_k0, st_k1, st_v0, st_v1;
#define LOADKV(Kg, Vg, k0) do { st_k0 = *(const bf16x8*)((Kg) + (size_t)((k0) + sr) * 128 + sc); st_k1 = *(const bf16x8*)((Kg) + (size_t)((k0) + 32 + sr) * 128 + sc); \
                                st_v0 = *(const bf16x8*)((Vg) + (size_t)((k0) + sr) * 128 + sc); st_v1 = *(const bf16x8*)((Vg) + (size_t)((k0) + 32 + sr) * 128 + sc); } while (0)
#define WRITEKV() do { *(bf16x8*)(K_lds + kws) = st_k0; *(bf16x8*)(K_lds + kws + 32 * 256) = st_k1; *(bf16x8*)(V_lds + vst0) = st_v0; *(bf16x8*)(V_lds + vst1) = st_v1; } while (0)
    if (tid == 0) *ANY = 0u;
    const float g0 = GATES[row * 24 + h * 3 + 0], g1 = GATES[row * 24 + h * 3 + 1], g2 = GATES[row * 24 + h * 3 + 2];
    f32x16 o[4];
    const unsigned olane = (unsigned)((4 * hi) * 1024 + r32) * 4u;
    float* otw = OTMP + ((size_t)b * SEQ + q0 + th * 32) * 1024 + h * 128;
    if constexpr (PART != 1) {
    {
        const bf16_t* kb = KW + ((size_t)b * 2 + g) * SEQ * 128; const bf16_t* vb = VW + ((size_t)b * 2 + g) * SEQ * 128;
        float m = -1e30f, l = 0.f;
#pragma unroll
        for (int d = 0; d < 4; ++d) o[d] = f32x16{};
        int jt = qt >= 8 ? qt - 8 : 0;
        LOADKV(kb, vb, 64 * jt);
        for (;;) {
            __syncthreads(); WRITEKV();
            if (jt < qt) LOADKV(kb, vb, 64 * (jt + 1));
            __syncthreads();
            const int lo = t - 511 - 64 * jt - 4 * hi, hiB = t - 64 * jt - 4 * hi + 1;
            f32x16 p0, p1; bias_init(p0, p1, cs * (float)(64 * jt - q0 + 4 * hi), cs);
            tile128(p0, p1, o, m, l, c1, K_lds, vb0, qr, __any(lo > 0 || hiB < 64) != 0, lo, hiB, al_l, r32, hi);
            if (jt == qt) break;
            ++jt;
        }
        scale_rows(o, g2 / l, al_l, r32, hi);
#pragma unroll
        for (int r = 0; r < 16; ++r) { unsigned lo_ = olane; asm volatile("" : "+v"(lo_)); float* op_ = (float*)((char*)otw + (lo_ + (unsigned)(((r & 3) + 8 * (r >> 2)) * 4096)));
#pragma unroll
            for (int d0 = 0; d0 < 4; ++d0) op_[d0 * 32] = o[d0][r]; }
    }
    }
    if constexpr (PART == 0) return;
    {
        const bf16_t* kc = KC + ((size_t)b * 2 + g) * 128 * 128; const bf16_t* vc = VC + ((size_t)b * 2 + g) * 128 * 128;
        const bool two = qt >= 16;
        const int nvalid = (t >= 31) ? ((t - 31) / 16 + 1) : 0;
        float m = -1e30f, l = 0.f;
#pragma unroll
        for (int d = 0; d < 4; ++d) o[d] = f32x16{};
        float mv[2][8], lv[2][8];
        LOADKV(kc, vc, 0); __syncthreads(); WRITEKV(); if (two) LOADKV(kc, vc, 64); __syncthreads();
        {   f32x16 p0, p1; bias_init(p0, p1, cs * (16.f * (4 * hi) + 15.5f - (float)q0), cs * 16.f);
            qkt128(p0, p1, K_lds, r32, hi, qr); mask_range(p0, p1, 0, nvalid - 4 * hi);
            float alpha; softmax_tile(p0, p1, m, l, c1, alpha);
#pragma unroll
            for (int j = 0; j < 4; ++j) { mv[0][j] = (p0[4 * j] + p0[4 * j + 1]) + (p0[4 * j + 2] + p0[4 * j + 3]); lv[0][j] = p0[4 * j + 3];
                                          mv[0][4 + j] = (p1[4 * j] + p1[4 * j + 1]) + (p1[4 * j + 2] + p1[4 * j + 3]); lv[0][4 + j] = p1[4 * j + 3]; }
            bf16x8 pa0, pa1, pa2, pa3; pack_p(p0, p1, pa0, pa1, pa2, pa3); SBAR(); pv_tile(o, vb0, pa0, pa1, pa2, pa3); }
        if (two) {
            __syncthreads(); WRITEKV(); __syncthreads();
            f32x16 p0, p1; bias_init(p0, p1, cs * (16.f * (64 + 4 * hi) + 15.5f - (float)q0), cs * 16.f);
            qkt128(p0, p1, K_lds, r32, hi, qr); mask_range(p0, p1, 0, nvalid - 64 - 4 * hi);
            float alpha; softmax_tile(p0, p1, m, l, c1, alpha);
            if (__any(alpha < 1.f)) scale_rows(o, alpha, al_l, r32, hi);
#pragma unroll
            for (int j = 0; j < 8; ++j) { mv[0][j] *= alpha; lv[0][j] *= alpha; }
#pragma unroll
            for (int j = 0; j < 4; ++j) { mv[1][j] = (p0[4 * j] + p0[4 * j + 1]) + (p0[4 * j + 2] + p0[4 * j + 3]); lv[1][j] = p0[4 * j + 3];
                                          mv[1][4 + j] = (p1[4 * j] + p1[4 * j + 1]) + (p1[4 * j + 2] + p1[4 * j + 3]); lv[1][4 + j] = p1[4 * j + 3]; }
            bf16x8 pa0, pa1, pa2, pa3; pack_p(p0, p1, pa0, pa1, pa2, pa3); SBAR(); pv_tile(o, vb0, pa0, pa1, pa2, pa3);
        } else {
#pragma unroll
            for (int j = 0; j < 8; ++j) { mv[1][j] = 0.f; lv[1][j] = 0.f; }
        }
        LOADKV(KS + ((size_t)b * 2 + g) * SEQ * 128, VS + ((size_t)b * 2 + g) * SEQ * 128, 0);
        const float inv = l > 0.f ? 1.0f / l : 0.f;
        const int R = hr * 64 + tok;
#pragma unroll
        for (int ti = 0; ti < 2; ++ti)
#pragma unroll
            for (int hf = 0; hf < 2; ++hf)
#pragma unroll
                for (int j = 0; j < 4; ++j) { const int s = 2 * j + hi + 8 * hf + 16 * ti; MAIN[R * 33 + s] = mv[ti][4 * hf + j] * inv; LAST[R * 33 + s] = lv[ti][4 * hf + j] * inv; }
        scale_rows(o, g0 * inv, al_l, r32, hi);
        {   float tmp[16][4];
#pragma unroll
            for (int r = 0; r < 16; ++r) { unsigned lo_ = olane; asm volatile("" : "+v"(lo_)); const float* op_ = (const float*)((const char*)otw + (lo_ + (unsigned)(((r & 3) + 8 * (r >> 2)) * 4096)));
#pragma unroll
                for (int d0 = 0; d0 < 4; ++d0) tmp[r][d0] = op_[d0 * 32]; }
#pragma unroll
            for (int r = 0; r < 16; ++r) { unsigned lo_ = olane; asm volatile("" : "+v"(lo_)); float* op_ = (float*)((char*)otw + (lo_ + (unsigned)(((r & 3) + 8 * (r >> 2)) * 4096)));
#pragma unroll
                for (int d0 = 0; d0 < 4; ++d0) op_[d0 * 32] = tmp[r][d0] + o[d0][r]; } }
    }
    __syncthreads();
    {
        const int tok2 = tid & 63, sg = tid >> 6, t2 = q0 + tok2;
#pragma unroll
        for (int i = 0; i < 4; ++i) { const int s = sg * 4 + i; float imp = 0.f;
#pragma unroll
            for (int rr = 0; rr < 4; ++rr) { imp += MAIN[(rr * 64 + tok2) * 33 + s]; if (s > 0) imp += LAST[(rr * 64 + tok2) * 33 + s - 1]; }
            const bool forced = (s == 0) || (s == qt), future = (64 * s > t2);
            IMP[tok2 * 33 + s] = future ? -1e30f : (forced ? 1e4f : imp); }
        __syncthreads();
        unsigned nib = 0u;
#pragma unroll
        for (int i = 0; i < 4; ++i) { const int s = sg * 4 + i; const float v = IMP[tok2 * 33 + s]; int rank = 0;
            for (int s2 = 0; s2 < 32; ++s2) { const float ov = IMP[tok2 * 33 + s2]; rank += (ov > v || (ov == v && s2 < s)) ? 1 : 0; }
            nib |= (rank < 8 ? 1u : 0u) << i; }
        SELB[tok2 * 8 + sg] = (unsigned char)nib;
        __syncthreads();
    }
    unsigned mymask = 0u;
    { const u32x2 wv = *(const u32x2*)(SELB + tok * 8);
#pragma unroll
      for (int k = 0; k < 4; ++k) { mymask |= ((wv.x >> (8 * k)) & 0xfu) << (4 * k); mymask |= ((wv.y >> (8 * k)) & 0xfu) << (16 + 4 * k); } }
    if (hr == 0 && hi == 0) atomicOr(ANY, mymask);
    __syncthreads();
    {
        const bf16_t* kb = KS + ((size_t)b * 2 + g) * SEQ * 128; const bf16_t* vb = VS + ((size_t)b * 2 + g) * SEQ * 128;
        unsigned rem = *ANY & (qt == 31 ? 0xffffffffu : ((1u << (qt + 1)) - 1u));
        rem = __builtin_amdgcn_readfirstlane(rem);
        float m = -1e30f, l = 0.f;
#pragma unroll
        for (int d = 0; d < 4; ++d) o[d] = f32x16{};
        int s = 0; rem &= rem - 1u;
        for (;;) {
            __syncthreads(); WRITEKV();
            const int sn = rem ? __builtin_ctz(rem) : -1;
            if (sn >= 0) { rem &= rem - 1u; LOADKV(kb, vb, 64 * sn); }
            __syncthreads();
            const bool sel = (mymask >> s) & 1u;
            const int hiB = sel ? (s == qt ? tok - 4 * hi + 1 : 64) : 0;
            if (__any(hiB > 0)) {
            f32x16 p0, p1; bias_init(p0, p1, cs * (float)(64 * s - q0 + 4 * hi), cs);
            tile128(p0, p1, o, m, l, c1, K_lds, vb0, qr, __any(hiB < 64) != 0, 0, hiB, al_l, r32, hi); }
            if (sn < 0) break;
            s = sn;
        }
        scale_rows(o, g1 / l, al_l, r32, hi);
        {   float tmp[16][4];
#pragma unroll
            for (int r = 0; r < 16; ++r) { unsigned lo_ = olane; asm volatile("" : "+v"(lo_)); const float* op_ = (const float*)((const char*)otw + (lo_ + (unsigned)(((r & 3) + 8 * (r >> 2)) * 4096)));
#pragma unroll
                for (int d0 = 0; d0 < 4; ++d0) tmp[r][d0] = op_[d0 * 32]; }
#pragma unroll
            for (int r = 0; r < 16; ++r)
#pragma unroll
                for (int d0 = 0; d0 < 4; ++d0) o[d0][r] += tmp[r][d0]; }
    }
    {
        {   float* sp = SSO + ((size_t)b * SEQ + q0 + th * 32) * 16 + h;
#pragma unroll
            for (int r = 0; r < 16; ++r) { float q = (o[0][r] * o[0][r] + o[1][r] * o[1][r]) + (o[2][r] * o[2][r] + o[3][r] * o[3][r]);
                q += __shfl_xor(q, 1); q += __shfl_xor(q, 2); q += __shfl_xor(q, 4); q += __shfl_xor(q, 8); q += __shfl_xor(q, 16);
                if (r32 == 0) sp[(size_t)crow(r, hi) * 16] = q; } }
        bf16_t* Ow = Hout + ((size_t)b * SEQ + q0 + th * 32) * DM + h * 128;
#pragma unroll
        for (int r = 0; r < 16; ++r) { unsigned lo_ = (unsigned)((4 * hi) * DM + r32) * 2u; asm volatile("" : "+v"(lo_)); char* op_ = (char*)Ow + (lo_ + (unsigned)(((r & 3) + 8 * (r >> 2)) * DM * 2));
#pragma unroll
            for (int d0 = 0; d0 < 4; ++d0) { const float v = o[d0][r]; const float vn = __shfl_xor(v, 1);
                if ((r32 & 1) == 0) *(unsigned*)(op_ + d0 * 64) = cvtpk(v, vn); } }
    }
    __syncthreads();
#undef LOADKV
#undef WRITEKV
}

DI void mla_unit(char* lds, int b, int h, int qb, const bf16_t* QM, const bf16_t* KM, const bf16_t* VM, const float* qgain, const float* ropet, float* SSO, bf16_t* Hout) {
    int tid = threadIdx.x; asm volatile("" : "+v"(tid));
    const int wid = __builtin_amdgcn_readfirstlane(tid >> 6), lane = tid & 63, r32 = lane & 31, hi = lane >> 5;
    const int q0 = qb * 256, w0 = q0 + wid * 32, t = w0 + r32;
    const size_t row = (size_t)b * SEQ + t;
    constexpr int MV = 0, MK = 2 * 16384, MKR = MK + 2 * 16384, MWS = MKR + 2 * 8192;
    char* V_lds = lds + MV; char* K_lds = lds + MK; char* KR_lds = lds + MKR; float* al_l = (float*)(lds + MWS) + wid * 64;
    const int vb0 = (int)(uintptr_t)V_lds + v_rd_base(lane);
    unsigned gK[2], gV[2], gR;
#pragma unroll
    for (int u = 0; u < 2; ++u) { const int ch = wid + 8 * u;
        { const int rw = 4 * ch + (lane >> 4), c = (lane & 15) ^ (rw & 7); gK[u] = (unsigned)(rw * 192 + c * 8) * 2u; }
        { const int g = 64 * ch + lane, blk = g >> 5, w = g & 31, kk = ((blk >> 2) << 3) | (w >> 2), k = (kk & ~0xC) | ((kk & 4) << 1) | ((kk & 8) >> 1), c = (blk & 3) * 32 + (w & 3) * 8; gV[u] = (unsigned)(k * 128 + c) * 2u; } }
    { const int rw = 8 * wid + (lane >> 3), c = (lane & 7) ^ ((rw >> 1) & 7); gR = (unsigned)(rw * 192 + 128 + c * 8) * 2u; }
    bf16x8 qr[12];
#pragma unroll
    for (int d0 = 0; d0 < 12; ++d0) qr[d0] = *(const bf16x8*)(QM + row * 1536 + h * 192 + d0 * 16 + hi * 8);
    {
        float ssq = 0.f;
#pragma unroll
        for (int d0 = 0; d0 < 12; ++d0)
#pragma unroll
            for (int j = 0; j < 8; ++j) { const float v = bf2f((bf16_t)qr[d0][j]); ssq = fmaf(v, v, ssq); }
        { auto rr = __builtin_amdgcn_permlane32_swap(__float_as_uint(ssq), __float_as_uint(ssq), false, false); ssq = __uint_as_float(rr[0]) + __uint_as_float(rr[1]); }
        const float rq = 1.0f / sqrtf(ssq * (1.0f / 192.0f) + EPS);
#pragma unroll
        for (int d0 = 0; d0 < 8; ++d0) { const f32x4 ga = *(const f32x4*)(qgain + d0 * 16 + hi * 8), gb = *(const f32x4*)(qgain + d0 * 16 + hi * 8 + 4);
            u32x4 w; w.x = cvtpk(bf2f((bf16_t)qr[d0][0]) * rq * ga[0], bf2f((bf16_t)qr[d0][1]) * rq * ga[1]); w.y = cvtpk(bf2f((bf16_t)qr[d0][2]) * rq * ga[2], bf2f((bf16_t)qr[d0][3]) * rq * ga[3]);
            w.z = cvtpk(bf2f((bf16_t)qr[d0][4]) * rq * gb[0], bf2f((bf16_t)qr[d0][5]) * rq * gb[1]); w.w = cvtpk(bf2f((bf16_t)qr[d0][6]) * rq * gb[2], bf2f((bf16_t)qr[d0][7]) * rq * gb[3]);
            qr[d0] = *reinterpret_cast<bf16x8*>(&w); }
#pragma unroll
        for (int dd = 0; dd < 2; ++dd) {
            const int i0 = 16 * dd + 8 * hi; const float* rp = ropet + ((size_t)t * 32 + i0) * 2; float o1[8], o2[8];
#pragma unroll
            for (int e = 0; e < 2; ++e) { const f32x4 g1 = *(const f32x4*)(qgain + 128 + i0 + 4 * e), g2 = *(const f32x4*)(qgain + 160 + i0 + 4 * e), cs0 = *(const f32x4*)(rp + 8 * e), cs1 = *(const f32x4*)(rp + 8 * e + 4);
#pragma unroll
                for (int j = 0; j < 4; ++j) { const float a = bf2f((bf16_t)qr[8 + dd][4 * e + j]) * rq * g1[j], c = bf2f((bf16_t)qr[10 + dd][4 * e + j]) * rq * g2[j];
                    const float co = j < 2 ? cs0[2 * j] : cs1[2 * (j - 2)], si = j < 2 ? cs0[2 * j + 1] : cs1[2 * (j - 2) + 1];
                    o1[4 * e + j] = a * co - c * si; o2[4 * e + j] = c * co + a * si; } }
            u32x4 w1, w2; w1.x = cvtpk(o1[0], o1[1]); w1.y = cvtpk(o1[2], o1[3]); w1.z = cvtpk(o1[4], o1[5]); w1.w = cvtpk(o1[6], o1[7]);
            w2.x = cvtpk(o2[0], o2[1]); w2.y = cvtpk(o2[2], o2[3]); w2.z = cvtpk(o2[4], o2[5]); w2.w = cvtpk(o2[6], o2[7]);
            qr[8 + dd] = *reinterpret_cast<bf16x8*>(&w1); qr[10 + dd] = *reinterpret_cast<bf16x8*>(&w2); }
    }
    const float c1 = 0.07216878364870322f * 1.4426950408889634f;
    const bf16_t* kb = KM + ((size_t)b * 8 + h) * SEQ * 192; const bf16_t* vb = VM + ((size_t)b * 8 + h) * SEQ * 128;
    PG8_LAS unsigned char* const ldsp = (PG8_LAS unsigned char*)lds;
#define DMAKV(k0, bf_) do { const char* kg_ = (const char*)(kb + (size_t)(k0) * 192); const char* vg_ = (const char*)(vb + (size_t)(k0) * 128); \
        _Pragma("unroll") for (int u_ = 0; u_ < 2; ++u_) { \
            __builtin_amdgcn_global_load_lds((const unsigned*)(kg_ + gK[u_]), (PG8_LAS unsigned*)(ldsp + MK + (bf_) * 16384 + (wid + 8 * u_) * 1024), 16, 0, 0); \
            __builtin_amdgcn_global_load_lds((const unsigned*)(vg_ + gV[u_]), (PG8_LAS unsigned*)(ldsp + MV + (bf_) * 16384 + (wid + 8 * u_) * 1024), 16, 0, 0); } \
        __builtin_amdgcn_global_load_lds((const unsigned*)(kg_ + gR), (PG8_LAS unsigned*)(ldsp + MKR + (bf_) * 8192 + wid * 1024), 16, 0, 0); } while (0)
    float m = -1e30f, l = 0.f; f32x16 o[4];
#pragma unroll
    for (int d = 0; d < 4; ++d) o[d] = f32x16{};
    const int ntile = 4 * qb + 4;
    __syncthreads();
    DMAKV(0, 0);
    for (int jt = 0; jt < ntile; ++jt) {
        const int bf = jt & 1;
        asm volatile("s_waitcnt vmcnt(0)" ::: "memory"); __builtin_amdgcn_s_barrier(); asm volatile("" ::: "memory");
        if (jt + 1 < ntile) DMAKV(64 * (jt + 1), bf ^ 1);
        if (64 * jt <= w0 + 31) {
            f32x16 p0 = f32x16{}, p1 = f32x16{};
            qkt128(p0, p1, K_lds + bf * 16384, r32, hi, qr); qkt_rope(p0, p1, KR_lds + bf * 8192, r32, hi, qr + 8);
            if (64 * jt + 63 > w0) mask_range(p0, p1, -4096, t - 64 * jt - 4 * hi + 1);
            float alpha; softmax_tile(p0, p1, m, l, c1, alpha);
            if (__any(alpha < 1.f)) scale_rows(o, alpha, al_l, r32, hi);
            bf16x8 pa0, pa1, pa2, pa3; pack_p(p0, p1, pa0, pa1, pa2, pa3); SBAR();
            pv_tile(o, vb0 + bf * 16384, pa0, pa1, pa2, pa3);
        }
    }
#undef DMAKV
    scale_rows(o, 1.0f / l, al_l, r32, hi);
    {
        {   float* sp = SSO + ((size_t)b * SEQ + w0) * 16 + 8 + h;
#pragma unroll
            for (int r = 0; r < 16; ++r) { float q = (o[0][r] * o[0][r] + o[1][r] * o[1][r]) + (o[2][r] * o[2][r] + o[3][r] * o[3][r]);
                q += __shfl_xor(q, 1); q += __shfl_xor(q, 2); q += __shfl_xor(q, 4); q += __shfl_xor(q, 8); q += __shfl_xor(q, 16);
                if (r32 == 0) sp[(size_t)crow(r, hi) * 16] = q; } }
        bf16_t* Ow = Hout + ((size_t)b * SEQ + w0) * DM + 1024 + h * 128;
#pragma unroll
        for (int r = 0; r < 16; ++r) { unsigned lo_ = (unsigned)((4 * hi) * DM + r32) * 2u; asm volatile("" : "+v"(lo_)); char* op_ = (char*)Ow + (lo_ + (unsigned)(((r & 3) + 8 * (r >> 2)) * DM * 2));
#pragma unroll
            for (int d0 = 0; d0 < 4; ++d0) { const float v = o[d0][r]; const float vn = __shfl_xor(v, 1);
                if ((r32 & 1) == 0) *(unsigned*)(op_ + d0 * 64) = cvtpk(v, vn); } }
    }
    __syncthreads();
}
#undef KSWZ
#undef SBAR
}

#define XB_TMO      128
#define XB_XCNT(j)  (256  + 64 * (j))
#define XB_XSUB(j)  (1280 + 64 * (j))
#define XB_XGEN(j)  (2304 + 64 * (j))
#define XB_TOP      3328
#define XB_TOPGEN   3392
#define XB2_XSUB(j) (3456 + 64 * (j))
#define XB2_TOP     4480
#define XB2_DONE    4544
#define XB_SET(i)   (3456 + 1152 * ((i) - 2))
#define XCD_BAR_WORDS 6912
#define XB_XCCTAB   6912
#define XB_SPIN_CAP (1u << 18)
#define LAS __attribute__((address_space(3)))
DI unsigned xb_ld(unsigned* p)              { return __hip_atomic_load(p, __ATOMIC_RELAXED, __HIP_MEMORY_SCOPE_AGENT); }
DI unsigned xb_add(unsigned* p, unsigned v) { return __hip_atomic_fetch_add(p, v, __ATOMIC_RELAXED, __HIP_MEMORY_SCOPE_AGENT); }
DI unsigned xb_xcc_id() { return (unsigned)__builtin_amdgcn_s_getreg((3 << 11) | 20) & 0xFu; }
#define XB_SPIN(cond, bar) do { unsigned _sp = 0; while (cond) { __builtin_amdgcn_s_sleep(1); \
    if ((++_sp & 255u) == 0u) { if (xb_ld(&(bar)[XB_TMO])) break; if (_sp > XB_SPIN_CAP) { atomicAdd(&(bar)[XB_TMO], 1u); break; } } } } while (0)
struct XcdBarrier { unsigned* bar; unsigned x; volatile LAS unsigned* st; };
DI XcdBarrier xcd_barrier_post(unsigned* bar, volatile LAS unsigned* st) {
    XcdBarrier b; b.bar = bar; b.x = xb_xcc_id(); b.st = st;
    if (threadIdx.x == 0) (void)xb_add(&bar[XB_XCNT(b.x)], 1u);
    return b;
}
DI void xcd_barrier_complete(unsigned* bar, unsigned x, unsigned& nloc, unsigned& nx) {
    const unsigned G = gridDim.x * gridDim.y * gridDim.z;
    unsigned sum, cnt, mine, sp = 0u;
    for (;;) {
        sum = 0u; cnt = 0u; mine = 0u;
#pragma unroll
        for (unsigned j = 0; j < 16; ++j) { const unsigned c = xb_ld(&bar[XB_XCNT(j)]); sum += c; cnt += (c > 0u) ? 1u : 0u; mine = (j == x) ? c : mine; }
        if (sum == G) break;
        __builtin_amdgcn_s_sleep(1);
        if ((++sp & 255u) == 0u) { if (xb_ld(&bar[XB_TMO])) break; if (sp > XB_SPIN_CAP) { atomicAdd(&bar[XB_TMO], 1u); break; } }
    }
    nloc = mine > 0u ? mine : 1u; nx = cnt > 0u ? cnt : 1u;
}
DI void xcd_barrier(const XcdBarrier& b) {
    asm volatile("s_waitcnt vmcnt(0)" ::: "memory");
    __syncthreads();
    if (threadIdx.x == 0) {
        unsigned* bar = b.bar;
        __builtin_amdgcn_s_waitcnt(0);
        unsigned nloc = b.st[0], nx = b.st[1];
        if (nloc == 0u) { xcd_barrier_complete(bar, b.x, nloc, nx); b.st[0] = nloc; b.st[1] = nx; }
        const unsigned old = xb_add(&bar[XB_XSUB(b.x)], 1u);
        const unsigned gen = old / nloc;
        if (old + 1u == (gen + 1u) * nloc) {
            __builtin_amdgcn_fence(__ATOMIC_RELEASE, "agent");
            asm volatile("s_waitcnt vmcnt(0)" ::: "memory");
            const unsigned og = xb_add(&bar[XB_TOP], 1u);
            const unsigned tg = og / nx;
            if (og + 1u == (tg + 1u) * nx) xb_add(&bar[XB_TOPGEN], 1u);
            else XB_SPIN(xb_ld(&bar[XB_TOPGEN]) == tg, bar);
            __builtin_amdgcn_fence(__ATOMIC_ACQUIRE, "agent");
            xb_add(&bar[XB_XGEN(b.x)], 1u);
            asm volatile("s_waitcnt vmcnt(0)" ::: "memory");
        } else {
            XB_SPIN(xb_ld(&bar[XB_XGEN(b.x)]) == gen, bar);
            __builtin_amdgcn_fence(__ATOMIC_ACQUIRE, "agent");
            asm volatile("s_waitcnt vmcnt(0)" ::: "memory");
        }
    }
    __syncthreads();
}

DI void xcd_barrier_local(const XcdBarrier& b) {
    asm volatile("s_waitcnt vmcnt(0)" ::: "memory");
    __syncthreads();
    if (threadIdx.x == 0) {
        unsigned* bar = b.bar;
        __builtin_amdgcn_s_waitcnt(0);
        unsigned nloc = b.st[0], nx = b.st[1];
        if (nloc == 0u) { xcd_barrier_complete(bar, b.x, nloc, nx); b.st[0] = nloc; b.st[1] = nx; }
        const unsigned old = xb_add(&bar[XB_XSUB(b.x)], 1u);
        const unsigned gen = old / nloc;
        if (old + 1u == (gen + 1u) * nloc) xb_add(&bar[XB_XGEN(b.x)], 1u);
        else XB_SPIN(xb_ld(&bar[XB_XGEN(b.x)]) == gen, bar);
        __builtin_amdgcn_fence(__ATOMIC_ACQUIRE, "agent");
        asm volatile("s_waitcnt vmcnt(0)" ::: "memory");
    }
    __syncthreads();
}
DI bool xcd_groups_local(unsigned* barw, int G) {
    int ok = (G == 256) ? 1 : 0;
    if (ok && threadIdx.x < 256) ok = (xb_ld(&barw[XB_XCCTAB + threadIdx.x]) == xb_ld(&barw[XB_XCCTAB + (threadIdx.x & 7)])) ? 1 : 0;
    return __syncthreads_and(ok) != 0;
}
DI void xcd_arrive_s(const XcdBarrier& b, int base) {
    asm volatile("s_waitcnt vmcnt(0)" ::: "memory");
    __syncthreads();
    if (threadIdx.x == 0) {
        unsigned* bar = b.bar;
        __builtin_amdgcn_s_waitcnt(0);
        unsigned nloc = b.st[0], nx = b.st[1];
        if (nloc == 0u) { xcd_barrier_complete(bar, b.x, nloc, nx); b.st[0] = nloc; b.st[1] = nx; }
        const unsigned old = xb_add(&bar[base + 64 * b.x], 1u);
        if (old + 1u == nloc) {
            __builtin_amdgcn_fence(__ATOMIC_RELEASE, "agent");
            asm volatile("s_waitcnt vmcnt(0)" ::: "memory");
            const unsigned og = xb_add(&bar[base + 1024], 1u);
            if (og + 1u == nx) xb_add(&bar[base + 1088], 1u);
            asm volatile("s_waitcnt vmcnt(0)" ::: "memory");
        }
    }
}
DI void xcd_wait_flag(unsigned* bar, int base, bool acquire) {
    if (threadIdx.x == 0) {
        XB_SPIN(xb_ld(&bar[base + 1088]) == 0u, bar);
        if (acquire) { __builtin_amdgcn_fence(__ATOMIC_ACQUIRE, "agent"); asm volatile("s_waitcnt vmcnt(0)" ::: "memory"); }
    }
    __syncthreads();
}
DI void xcd_arrive2(const XcdBarrier& b) { xcd_arrive_s(b, XB_SET(2)); }
DI void xcd_wait_s(const XcdBarrier& b, int base, bool acquire) { xcd_wait_flag(b.bar, base, acquire); }
static_assert(XB_SET(2) == 3456, "nsa_unit waits on set 2");

struct P6Order {
    const bf16_t *cq, *wuq, *ckv, *wukv, *kcmp, *vcmp, *w1k, *w1v; int G, c;
    DI void four(int f, pg8::Unit& u) const {
        if (f < 256) { const int pm = f >> 3, pn = f & 7; u.A = (const char*)(ckv + (size_t)pm * 256 * 256); u.B = (const char*)(wukv + (size_t)pn * 256 * 256);
            u.pm = pm; u.pn = pn; u.aux = 0; u.type = 1; }
        else { const int e = f - 256, pm = e & 1, sp = (e >> 1) & 15, g = (e >> 5) & 1, kv = e >> 6;
            u.A = (const char*)((kv ? vcmp : kcmp) + (size_t)g * NB * SEQ * 128 + (size_t)pm * 256 * 2048 + sp * 256); u.B = (const char*)((kv ? w1v : w1k) + sp * 256);
            u.pm = pm; u.pn = 0; u.aux = (kv * 2 + g) * NSPLIT + sp; u.type = 2; }
    }
    DI void qunit(int j, pg8::Unit& u) const { const int pm = j / 6, pn = j - 6 * pm; u.A = (const char*)(cq + (size_t)pm * 256 * 384); u.B = (const char*)(wuq + (size_t)pn * 256 * 384);
        u.pm = pm; u.pn = pn; u.aux = 0; u.type = 0; }
    DI bool next(int i, pg8::Unit& u) const {
        if (G == 256) {
            if (c < 192) { if (i == 0) { qunit(c, u); return true; } if (i == 1) { four(64 + c, u); return true; } return false; }
            if (i > 2) return false; four((i == 0 ? 0 : (i == 1 ? 256 : 320)) + (c - 192), u); return true;
        }
        const int L = i * G + c; if (L >= 576) return false;
        if (L < 192) qunit(L, u); else four(L - 192, u); return true;
    }
};
struct CmpOrder {
    const bf16_t *kcmp, *vcmp, *w1k, *w1v; int G, c;
    DI bool next(int i, pg8::Unit& u) const {
        const int L = i * G + c; if (L >= 8 * NSPLIT) return false;
        const int pm = L & 1, sp = (L >> 1) % NSPLIT, g = (L / (2 * NSPLIT)) & 1, kv = L / (4 * NSPLIT);
        u.A = (const char*)((kv ? vcmp : kcmp) + (size_t)g * NB * SEQ * 128 + (size_t)pm * 256 * 2048 + sp * (4096 / NSPLIT));
        u.B = (const char*)((kv ? w1v : w1k) + sp * (4096 / NSPLIT)); u.pm = pm; u.pn = 0; u.aux = (kv * 2 + g) * NSPLIT + sp; return true;
    }
};
struct CmpFinalize {
    unsigned char* ws; const float* w2k; const float* w2v; const float* kgain; char* lds;
    DI void operator()() const {
        const int G = (int)gridDim.x, bid = (int)blockIdx.x;
        const bool fast = (G == 256) && (((volatile LAS unsigned*)((PG8_LAS unsigned char*)lds + (LDS_BYTES - 64)))[2] != 0u);
        int tid = threadIdx.x; asm volatile("" : "+v"(tid)); const int lane = tid & 63, wid = tid >> 6;
        const XcdBarrier xb{(unsigned*)(ws + WS_BAR), xb_xcc_id(), (volatile LAS unsigned*)((PG8_LAS unsigned char*)lds + (LDS_BYTES - 64))};
        if (fast) xcd_wait_flag(xb.bar, XB_SET(2), true);
        float* hid = (float*)(lds + att::L_MAIN) + wid * 256;
        const int ngw = G * 8, nrows = 2 * NB * 2 * 128;
        for (int it = bid * 8 + wid; it < nrows; it += ngw) {
            int n, g, b, kv;
            if (fast) { const int v = bid & 7, j = (bid >> 3) * 8 + wid; b = v >> 1; g = v & 1; kv = j >> 7; n = j & 127; }
            else { n = it & 127; g = (it >> 7) & 1; b = (it >> 8) & 3; kv = it >> 10; }
            bf16_t* dst = (bf16_t*)(ws + (kv ? WS_VC : WS_KC)) + (((size_t)b * 2 + g) * 128 + n) * 128;
            if (n == 127) { *(unsigned*)(dst + 2 * lane) = 0u; continue; }
            const float* w2 = kv ? w2v : w2k;
#pragma unroll
            for (int i = 0; i < 4; ++i) {
                const int k = lane + 64 * i; float a = 0.f;
                for (int sp = 0; sp < NSPLIT; ++sp) a += ((const float*)(ws + WS_CSLAB))[((size_t)((kv * 2 + g) * NSPLIT + sp) * 512 + b * 128 + n) * 256 + k];
                a += ((const float*)(ws + WS_BIASP))[2 * NBIASP * 256 + kv * 256 + k];
                const float t3 = 0.7978845608028654f * (a + 0.044715f * a * a * a);
                hid[k] = 0.5f * a * (1.0f + tanhf(t3));
            }
            __builtin_amdgcn_s_waitcnt(0xc07f); asm volatile("" ::: "memory");
            float o0 = 0.f, o1 = 0.f;
            {   float p0[4] = {0.f, 0.f, 0.f, 0.f}, p1[4] = {0.f, 0.f, 0.f, 0.f};
                for (int k0 = 0; k0 < 256; k0 += 16) {
                    f32x2 w[16];
#pragma unroll
                    for (int u = 0; u < 16; ++u) w[u] = *(const f32x2*)(w2 + (size_t)(k0 + u) * 128 + 2 * lane);
#pragma unroll
                    for (int u = 0; u < 16; ++u) { const float hk = hid[k0 + u]; p0[u & 3] = fmaf(hk, w[u].x, p0[u & 3]); p1[u & 3] = fmaf(hk, w[u].y, p1[u & 3]); }
                }
                o0 = (p0[0] + p0[1]) + (p0[2] + p0[3]); o1 = (p1[0] + p1[1]) + (p1[2] + p1[3]); }
            if (kv == 0) { const float rr = 1.0f / sqrtf(wave_sum(o0 * o0 + o1 * o1) * (1.0f / 128.0f) + EPS); o0 *= rr * kgain[2 * lane]; o1 *= rr * kgain[2 * lane + 1]; }
            *(unsigned*)(dst + 2 * lane) = pk2(o0, o1);
            __builtin_amdgcn_s_waitcnt(0xc07f); asm volatile("" ::: "memory");
        }
        if (fast) xcd_barrier_local(xb); else xcd_barrier(xb);
    }
};

__global__ void __launch_bounds__(NTHREADS, 2) mega(Args args) {
    extern __shared__ __attribute__((aligned(16))) char lds[];
    const int tid = threadIdx.x, lane = tid & 63, wid = tid >> 6;
    const int G = gridDim.x, bid = blockIdx.x;
    const int gw = bid * 8 + wid, ngw = G * 8;
    unsigned char* ws = args.ws;
    const float* x = args.in[0];
    float* out = args.out;
#define WGU1 ((bf16_t*)(ws + WS_WGU1))
#define WD1 ((bf16_t*)(ws + WS_WD1))
#define WGU2 ((bf16_t*)(ws + WS_WGU2))
#define WD2 ((bf16_t*)(ws + WS_WD2))
#define WIN ((bf16_t*)(ws + WS_WIN))
#define WOUT ((bf16_t*)(ws + WS_WOUT))
#define WUQ ((bf16_t*)(ws + WS_WUQ))
#define WUKV ((bf16_t*)(ws + WS_WUKV))
#define WC1K ((bf16_t*)(ws + WS_WC1K))
#define WC1V ((bf16_t*)(ws + WS_WC1V))
#define H ((bf16_t*)(ws + WS_H))
#define ACT ((bf16_t*)(ws + WS_ACT))
#define PROJ ((bf16_t*)(ws + WS_PROJ))
#define QM ((bf16_t*)(ws + WS_QM))
#define KNRAW ((bf16_t*)(ws + WS_KNRAW))
#define KM ((bf16_t*)(ws + WS_KM))
#define VM ((bf16_t*)(ws + WS_VM))
#define QN ((bf16_t*)(ws + WS_QN))
#define KS ((bf16_t*)(ws + WS_KS))
#define VS ((bf16_t*)(ws + WS_VS))
#define KW ((bf16_t*)(ws + WS_KW))
#define VW ((bf16_t*)(ws + WS_VW))
#define KCMP ((bf16_t*)(ws + WS_KCMP))
#define VCMP ((bf16_t*)(ws + WS_VCMP))
#define CQ ((bf16_t*)(ws + WS_CQ))
#define CKV ((bf16_t*)(ws + WS_CKV))
#define KROPE ((float*)(ws + WS_KROPE))
#define GATES ((float*)(ws + WS_GATES))
#define KC ((bf16_t*)(ws + WS_KC))
#define VC ((bf16_t*)(ws + WS_VC))
#define SS ((float*)(ws + WS_SS))
#define SSO ((float*)(ws + WS_SSO))
#define H2 ((bf16_t*)(ws + WS_H2))
#define H2F8 (ws + WS_ACT + 44 * MiB)
#define BIASP ((float*)(ws + WS_BIASP))
#define ROPE ((float*)(ws + WS_ROPE))
#define SLAB ((float*)(ws + WS_SLAB))
#define X1B ((bf16_t*)out)
#define BIAS1 (BIASP + 2 * NBIASP * 256)
    PG8_LAS unsigned char* ldsp = (PG8_LAS unsigned char*)lds;
    unsigned* barw = (unsigned*)(ws + WS_BAR);
    volatile LAS unsigned* xst = (volatile LAS unsigned*)(ldsp + (LDS_BYTES - 64));
    if (tid < 3) xst[tid] = 0u;
    if (tid == 0) barw[XB_XCCTAB + (bid & 255)] = xb_xcc_id();
#if !MK_NO_CG
    if (bid == 0) for (int i = tid; i < XCD_BAR_WORDS; i += NTHREADS) barw[i] = 0u;
#endif
#define xbar (XcdBarrier{(unsigned*)(args.ws + WS_BAR), xb_xcc_id(), (volatile LAS unsigned*)(ldsp + (LDS_BYTES - 64))})
#define local_ok (xst[2] != 0u)
    __syncthreads();
#if MK_NO_CG
    (void)xcd_barrier_post(barw, xst);
#endif
    const int lo = args.ph_lo, hi = args.ph_hi;
#ifndef PHASE_MASK
#define PHASE_MASK 0xffffffffu
#endif
#ifndef REPEAT_MASK
#define REPEAT_MASK 0u
#endif
#define IN(k) (((PHASE_MASK >> (k)) & 1u) && lo <= (k) && (k) < hi)
#if MK_ONE_LAUNCH
#if MK_NO_CG
#define SEAM(k) do { if (IN(k) && IN((k) + 1)) { xcd_barrier(xbar); if ((k) == 0) { const bool lk_ = xcd_groups_local(barw, G); if (threadIdx.x == 0) xst[2] = lk_ ? 1u : 0u; __syncthreads(); } } } while (0)
#else
#define SEAM(k) do { if (IN(k) && IN((k) + 1)) { if ((k) == 0) { cg::this_grid().sync(); (void)xcd_barrier_post(barw, xst); { const bool lk_ = xcd_groups_local(barw, G); if (threadIdx.x == 0) xst[2] = lk_ ? 1u : 0u; __syncthreads(); } } else xcd_barrier(xbar); } } while (0)
#endif
#define SEAML(k, k2) do { if (IN(k) && IN(k2)) { if (local_ok) xcd_barrier_local(xbar); else xcd_barrier(xbar); } } while (0)
#define NREP(k) (1 + (int)((REPEAT_MASK >> (k)) & 1u))
#define PH(k) for (int rep_ = 0; rep_ < NREP(k); ((rep_ + 1 < NREP(k)) ? cg::this_grid().sync() : (void)0, ++rep_)) if (IN(k))
#else
#define PH(k) if (IN(k))
#define SEAM(k) do { } while (0)
#endif

    PH(0) { size_t wsz_ = 0; asm volatile("" : "+s"(wsz_)); unsigned char* ws = args.ws + wsz_;     int tid = threadIdx.x; asm volatile("" : "+v"(tid)); const int lane = tid & 63, wid = tid >> 6, gw = bid * 8 + wid; (void)lane; (void)gw;
        float* scr = (float*)lds + wid * (64 * 33);
        transpose_all<MapGU, I8_W_SCALE, true>(args.in[2], DM, DFF, WGU1, MapGU{0}, nullptr, scr, gw, ngw, lane);
        transpose_all<MapGU, I8_W_SCALE, true>(args.in[3], DM, DFF, WGU1, MapGU{1}, nullptr, scr, gw, ngw, lane);
        transpose_all<MapGU, I8_W_SCALE, true>(args.in[25], DM, DFF, WGU2, MapGU{0}, args.in[24], scr, gw, ngw, lane, nullptr, 1 << 30, WGU2_GC, 1 << 30);
        transpose_all<MapGU, I8_W_SCALE, true>(args.in[26], DM, DFF, WGU2, MapGU{1}, args.in[24], scr, gw, ngw, lane, nullptr, 1 << 30, WGU2_DEF1, 1 << 30);
        transpose_all(args.in[6], DM, 3288, WIN, MapWin{}, args.in[5], scr, gw, ngw, lane);
        for (int i = bid * NTHREADS + tid; i < 40 * 256; i += G * NTHREADS) ((u32x4*)(WIN + (size_t)3032 * DM))[i] = (u32x4){0u, 0u, 0u, 0u};
        for (int it = bid; it < 2 * NBIASP; it += G) {
            const int kv = it / NBIASP, p = it % NBIASP; const float* pos = args.in[kv ? 12 : 9]; const float* w1 = args.in[kv ? 13 : 10];
            if (tid < 256) { float s = 0.f;
                for (int k0 = 128 * p; k0 < 128 * p + 128; k0 += 32) {
                    float wv[32];
#pragma unroll
                    for (int j = 0; j < 32; ++j) wv[j] = w1[(size_t)(k0 + j) * 256 + tid];
#pragma unroll
                    for (int j = 0; j < 32; ++j) s += pos[k0 + j] * wv[j]; }
                BIASP[(kv * NBIASP + p) * 256 + tid] = s; }
        }
        for (int i = bid * NTHREADS + tid; i < SEQ * 32; i += G * NTHREADS) {
            const int p = i >> 5, f = i & 31; const float inv = powf(10000.0f, -(float)f / 32.0f); const float ang = (float)p * inv;
            ROPE[2 * i] = cosf(ang); ROPE[2 * i + 1] = sinf(ang);
        }
        for (int r = gw; r < T; r += ngw) rmsnorm_row2048_i8(x + (size_t)r * DM, args.in[1], (unsigned char*)H + (size_t)r * DM, lane);
    }
    SEAM(0);
    PH(1) { size_t wsz_ = 0; asm volatile("" : "+s"(wsz_)); unsigned char* ws = args.ws + wsz_;     int tid = threadIdx.x; asm volatile("" : "+v"(tid)); const int lane = tid & 63, wid = tid >> 6, gw = bid * 8 + wid; (void)lane; (void)gw;
        pg8::TileOrder S; S.init(H, WGU1, DM / 2, DM / 2, T, 2 * DFF, G, bid);
        pg8::gemm_phase<pg8::EpiSwiglu, pg8::TileOrder, true, false, 0, 2>(ldsp, pg8::Gemm{DM / 2, DM / 2, DM / 2}, S, pg8::EpiSwiglu{ACT, nullptr, 1.0f / (I8_H1_SCALE * (float)I8_W_SCALE)});
        {   int t2 = threadIdx.x; asm volatile("" : "+v"(t2)); const int lane2 = t2 & 63, wid2 = t2 >> 6;
            const bool conv = (G != 256) || bid >= 128; const int gwc = (G == 256) ? (bid - 128) * 8 + wid2 : bid * 8 + wid2, ngwc = (G == 256) ? 1024 : ngw;
            if (conv) { transpose_all(args.in[4], DFF, DM, WD1, MapId{0}, nullptr, (float*)lds + wid2 * (64 * 33), gwc, ngwc, lane2);
                transpose_all<MapGU, I8_W_SCALE, true>(args.in[26], DM, DFF, WGU2, MapGU{1}, args.in[24], (float*)lds + wid2 * (64 * 33), gwc, ngwc, lane2, nullptr, 1 << 30, 0, WGU2_DEF0); } }
    }
    SEAM(1);
    PH(2) { size_t wsz_ = 0; asm volatile("" : "+s"(wsz_)); unsigned char* ws = args.ws + wsz_;     int tid = threadIdx.x; asm volatile("" : "+v"(tid)); const int lane = tid & 63, wid = tid >> 6, gw = bid * 8 + wid; (void)lane; (void)gw;
        pg8::TileOrder S; S.init(ACT, WD1, DFF, DFF, T, DM, G, bid);
        pg8::gemm_phase<pg8::EpiResidStat<false, false>, pg8::TileOrder, true>(ldsp, pg8::Gemm{DFF, DFF, DFF}, S, pg8::EpiResidStat<false, false>{x, 0.5f, X1B, SS, nullptr, nullptr});
    }
    SEAML(2, 4);
    PH(4) { size_t wsz_ = 0; asm volatile("" : "+s"(wsz_)); unsigned char* ws = args.ws + wsz_;     int tid = threadIdx.x; asm volatile("" : "+v"(tid)); const int lane = tid & 63, wid = tid >> 6, gw = bid * 8 + wid; (void)lane; (void)gw;
        pg8::TileOrder S; S.init(X1B, WIN, DM, DM, T, NPROJ, G, bid);
        const pg8::EpiProj E{ws, args.in[7], args.in[8], (PG8_LAS float*)(ldsp + pg8::STAGE_BYTES)};
        pg8::gemm_phase<pg8::EpiProj, pg8::TileOrder, true>(ldsp, pg8::Gemm{DM, DM, DM}, S, E);
        {
            int t2 = tid; asm volatile("" : "+v"(t2)); const int lane2 = t2 & 63, wid2 = t2 >> 6;
            const bool sub = (G == 256); float* scr = (float*)lds + wid2 * (64 * 33);
            if (!sub || bid >= 160) { const int gw2 = sub ? (bid - 160) * 8 + wid2 : bid * 8 + wid2, ngw2 = sub ? 96 * 8 : ngw;
                transpose_all(args.in[16], 384, 1536, WUQ, MapId{0}, args.in[15], scr, gw2, ngw2, lane2, args.in[15], 1 << 30);
                transpose_all(args.in[18], 256, 2048, WUKV, MapId{0}, args.in[17], scr, gw2, ngw2, lane2, args.in[17], 1 << 30);
                transpose_all(args.in[10], 4096, 256, WC1K, MapId{0}, nullptr, scr, gw2, ngw2, lane2);
                transpose_all(args.in[13], 4096, 256, WC1V, MapId{0}, nullptr, scr, gw2, ngw2, lane2);
                transpose_all(args.in[23], DM, DM, WOUT, MapId{0}, args.in[21], scr, gw2, ngw2, lane2, args.in[22], 1024);
                transpose_all<MapGU, I8_W_SCALE, true>(args.in[26], DM, DFF, WGU2, MapGU{1}, args.in[24], scr, gw2, ngw2, lane2, nullptr, 1 << 30, WGU2_DEF0, WGU2_DEF1);
                transpose_all<MapGU, I8_W_SCALE, true>(args.in[25], DM, DFF, WGU2, MapGU{0}, args.in[24], scr, gw2, ngw2, lane2, nullptr, 1 << 30, 0, WGU2_GDEF); } }
    }
    SEAM(4);
    PH(6) { size_t wsz_ = 0; asm volatile("" : "+s"(wsz_)); unsigned char* ws = args.ws + wsz_;     int tid = threadIdx.x; asm volatile("" : "+v"(tid)); const int lane = tid & 63, wid = tid >> 6, gw = bid * 8 + wid; (void)lane; (void)gw;
#ifndef P6SUB
#define P6SUB 7
#endif
#if P6_MERGED
        {   const P6Order S{CQ, WUQ, CKV, WUKV, KCMP, VCMP, WC1K, WC1V, G, bid};
            const pg8::EpiP6 E{pg8::EpiBf16{QM, 1536, (const float*)(ws + WS_SSQCQ)}, pg8::EpiKV{ws, args.in[20], (PG8_LAS float*)(ldsp + pg8::STAGE_BYTES)}, pg8::EpiSlab{(float*)(ws + WS_CSLAB)}};
            pg8::gemm_phase<pg8::EpiP6, P6Order, true, true>(ldsp, pg8::Gemm{384, 384, 384}, S, E); }
#else
        if (bid < 2 && tid < 256) { float sb = 0.f; for (int pp = 0; pp < NBIASP; ++pp) sb += BIASP[(bid * NBIASP + pp) * 256 + tid]; BIAS1[bid * 256 + tid] = sb; }
        {   pg8::TileOrder S; S.init(CQ, WUQ, 384, 384, T, 1536, G, bid);
            pg8::gemm_phase<pg8::EpiBf16, pg8::TileOrder, true>(ldsp, pg8::Gemm{384, 384, 384}, S, pg8::EpiBf16{QM, 1536, (const float*)(ws + WS_SSQCQ)});
            if (G == 256 && bid >= 192) { int t2 = tid; asm volatile("" : "+v"(t2)); const int lane2 = t2 & 63, wid2 = t2 >> 6;
                transpose_all<MapGU, I8_W_SCALE, true>(args.in[25], DM, DFF, WGU2, MapGU{0}, args.in[24], (float*)lds + wid2 * (64 * 33), (bid - 192) * 8 + wid2, 512, lane2, nullptr, 1 << 30, WGU2_GDEF, WGU2_GQ);
                __syncthreads(); } }
        {   pg8::TileOrder S; S.init(CKV, WUKV, 256, 256, T, 2048, G, bid);
            pg8::gemm_phase<pg8::EpiKV, pg8::TileOrder, true>(ldsp, pg8::Gemm{256, 256, 256}, S, pg8::EpiKV{ws, args.in[20], (PG8_LAS float*)(ldsp + pg8::STAGE_BYTES)}); }
        {   const CmpOrder S{KCMP, VCMP, WC1K, WC1V, G, bid};
            pg8::gemm_phase<pg8::EpiSlab, CmpOrder, true>(ldsp, pg8::Gemm{2048, 4096, 4096 / NSPLIT}, S, pg8::EpiSlab{(float*)(ws + WS_CSLAB)});
            {   int t2 = tid; asm volatile("" : "+v"(t2)); const int lane2 = t2 & 63, wid2 = t2 >> 6;
                if (G == 256 && bid >= 128) transpose_all<MapGU, I8_W_SCALE, true>(args.in[25], DM, DFF, WGU2, MapGU{0}, args.in[24], (float*)lds + wid2 * (64 * 33), (bid - 128) * 8 + wid2, 1024, lane2, nullptr, 1 << 30, WGU2_GQ, WGU2_GC);
                else if (G != 256) transpose_all<MapGU, I8_W_SCALE, true>(args.in[25], DM, DFF, WGU2, MapGU{0}, args.in[24], (float*)lds + wid2 * (64 * 33), bid * 8 + wid2, ngw, lane2, nullptr, 1 << 30, WGU2_GDEF, WGU2_GC); } }
#endif
    }
    do { if (IN(6) && IN(8)) { if (G == 256 && local_ok) xcd_arrive2(xbar); else xcd_barrier(xbar); } } while (0);
    PH(8) { size_t wsz_ = 0; asm volatile("" : "+s"(wsz_)); unsigned char* ws = args.ws + wsz_;     int tid = threadIdx.x; asm volatile("" : "+v"(tid)); const int lane = tid & 63, wid = tid >> 6, gw = bid * 8 + wid; (void)lane; (void)gw;
        const CmpFinalize mid{ws, args.in[11], args.in[14], args.in[8], lds};
#ifndef P8SUB
#define P8SUB 3
#endif
        for (int c = bid; c < 256; c += G) { const int bg = c & 7, qt = c >> 3; if (P8SUB & 1) att::nsa_unit<0>(lds, bg >> 1, bg & 1, qt, ws); }
        mid();
        for (int c = bid; c < 256; c += G) {
            const int bg = c & 7, qt = c >> 3;
            if (P8SUB & 1) att::nsa_unit<1>(lds, bg >> 1, bg & 1, qt, ws);
            const int bh = bg * 4 + ((31 - qt) & 3), qb = (31 - qt) >> 2;
            if (P8SUB & 2) att::mla_unit(lds, bh >> 3, bh & 7, qb, QM, KM, VM, args.in[19], ROPE, SSO, H);
        }
    }
    SEAM(8);
    PH(10) { size_t wsz_ = 0; asm volatile("" : "+s"(wsz_)); unsigned char* ws = args.ws + wsz_;     int tid = threadIdx.x; asm volatile("" : "+v"(tid)); const int lane = tid & 63, wid = tid >> 6, gw = bid * 8 + wid; (void)lane; (void)gw;
        pg8::TileOrder S; S.init(H, WOUT, DM, DM, T, DM, G, bid);
        pg8::gemm_phase<pg8::EpiResidStat<true, true>, pg8::TileOrder, true>(ldsp, pg8::Gemm{DM, DM, DM}, S, pg8::EpiResidStat<true, true>{X1B, 1.0f, H2, SS, SSO, H2F8});
    }
    SEAML(10, 12);
    PH(12) { size_t wsz_ = 0; asm volatile("" : "+s"(wsz_)); unsigned char* ws = args.ws + wsz_;     int tid = threadIdx.x; asm volatile("" : "+v"(tid)); const int lane = tid & 63, wid = tid >> 6, gw = bid * 8 + wid; (void)lane; (void)gw;
        {   int t2 = threadIdx.x; asm volatile("" : "+v"(t2)); const int lane2 = t2 & 63, wid2 = t2 >> 6;
            const bool conv = (G != 256) || bid >= 128; const int gwc = (G == 256) ? (bid - 128) * 8 + wid2 : bid * 8 + wid2, ngwc = (G == 256) ? 1024 : ngw;
            if (conv) transpose_all<MapId, F8_WD_SCALE>(args.in[27], DFF, DM, WD2, MapId{0}, nullptr, (float*)lds + wid2 * (64 * 33), gwc, ngwc, lane2); }
        xcd_arrive_s(xbar, XB_SET(3));
        pg8::TileOrder S; S.init((const bf16_t*)H2F8, WGU2, DM / 2, DM / 2, T, 2 * DFF, G, bid);
        pg8::gemm_phase<pg8::EpiSwigluT<true, true>, pg8::TileOrder, true, false, 0, 2>(ldsp, pg8::Gemm{DM / 2, DM / 2, DM / 2}, S, pg8::EpiSwigluT<true, true>{ACT, SS, 1.0f / (I8_X2_SCALE * (float)I8_W_SCALE)});
    }
    do { if (IN(12) && IN(13)) { if (local_ok) { xcd_wait_s(xbar, XB_SET(3), false); xcd_barrier_local(xbar); } else xcd_barrier(xbar); } } while (0);
    PH(13) { size_t wsz_ = 0; asm volatile("" : "+s"(wsz_)); unsigned char* ws = args.ws + wsz_;     int tid = threadIdx.x; asm volatile("" : "+v"(tid)); const int lane = tid & 63, wid = tid >> 6, gw = bid * 8 + wid; (void)lane; (void)gw;
        pg8::TileOrder S; S.init(ACT, WD2, DFF / 2, DFF / 2, T, DM, G, bid);
        pg8::gemm_phase<pg8::EpiResid, pg8::TileOrder, true, false, 0, 1>(ldsp, pg8::Gemm{DFF / 2, DFF / 2, DFF / 2}, S, pg8::EpiResid{H2, out, 0.5f / ((float)F8_WD_SCALE * F8_ASCALE)});
    }
#ifdef PROBE_ID
    cg::this_grid().sync();
    if (PROBE_ID == 1) { pg8::TileOrder S; S.init(H2, WGU2, DM, DM, T, 2 * DFF, G, bid); pg8::gemm_phase<pg8::EpiNull, pg8::TileOrder, true>(ldsp, pg8::Gemm{DM, DM, DM}, S, pg8::EpiNull{}); }
    if (PROBE_ID == 2) { pg8::TileOrder S; S.init(ACT, WD2, DFF, DFF, T, DM, G, bid); pg8::gemm_phase<pg8::EpiNull, pg8::TileOrder, true>(ldsp, pg8::Gemm{DFF, DFF, DFF}, S, pg8::EpiNull{}); }
    if (PROBE_ID == 3) { }
    if (PROBE_ID == 16) { pg8::TileOrder S; S.init(ACT, WD2, DFF / 2, DFF / 2, T, DM, G, bid); pg8::gemm_phase<pg8::EpiNull, pg8::TileOrder, true, false, 0, true>(ldsp, pg8::Gemm{DFF / 2, DFF / 2, DFF / 2}, S, pg8::EpiNull{}); }
    if (PROBE_ID == 17) { pg8::TileOrder S; S.init(ACT, WD2, DFF / 2, DFF / 2, T, DM, G, bid); pg8::gemm_phase<pg8::EpiNull, pg8::TileOrder, true, false, 1, true>(ldsp, pg8::Gemm{DFF / 2, DFF / 2, DFF / 2}, S, pg8::EpiNull{}); }
    if (PROBE_ID == 18) { pg8::TileOrder S; S.init(ACT, WD2, DFF / 2, DFF / 2, T, DM, G, bid); pg8::gemm_phase<pg8::EpiNull, pg8::TileOrder, true, false, 2, true>(ldsp, pg8::Gemm{DFF / 2, DFF / 2, DFF / 2}, S, pg8::EpiNull{}); }
    if (PROBE_ID == 14) { pg8::TileOrder S; S.init(H2, WGU2, DM, DM, T, 2 * DFF, G, bid); pg8::gemm_phase<pg8::EpiNull, pg8::TileOrder, true, false, 1>(ldsp, pg8::Gemm{DM, DM, DM}, S, pg8::EpiNull{}); }
    if (PROBE_ID == 15) { pg8::TileOrder S; S.init(H2, WGU2, DM, DM, T, 2 * DFF, G, bid); pg8::gemm_phase<pg8::EpiNull, pg8::TileOrder, true, false, 2>(ldsp, pg8::Gemm{DM, DM, DM}, S, pg8::EpiNull{}); }
    if (PROBE_ID == 13) { int tid = threadIdx.x; asm volatile("" : "+v"(tid)); const int lane = tid & 63, wid = tid >> 6, gw = bid * 8 + wid;
        float* hid = (float*)lds + wid * 256;
        for (int rid = gw; rid < 2 * NB * 2 * 128; rid += ngw) {
            const int n = rid & 127, g = (rid >> 7) & 1, b = (rid >> 8) & 3, kv = rid >> 10;
            bf16_t* dst = (kv ? VC : KC) + (((size_t)b * 2 + g) * 128 + n) * 128;
            if (n == 127) { *(unsigned*)(dst + 2 * lane) = 0u; continue; }
            const float* w2 = args.in[kv ? 14 : 11];
#pragma unroll
            for (int i = 0; i < 4; ++i) {
                const int k = lane + 64 * i; float a = 0.f;
                for (int sp = 0; sp < NSPLIT; ++sp) a += SLAB[((size_t)((kv * 2 + g) * NSPLIT + sp) * 512 + b * 128 + n) * 256 + k];
                a += BIAS1[kv * 256 + k];
                const float t3 = 0.7978845608028654f * (a + 0.044715f * a * a * a);
                hid[k] = 0.5f * a * (1.0f + tanhf(t3));
            }
            __builtin_amdgcn_s_waitcnt(0xc07f); asm volatile("" ::: "memory");
            float o0 = 0.f, o1 = 0.f;
            for (int k = 0; k < 256; ++k) { const float hk = hid[k]; const f32x2 w = *(const f32x2*)(w2 + (size_t)k * 128 + 2 * lane); o0 += hk * w.x; o1 += hk * w.y; }
            if (kv == 0) { const float* kg0 = args.in[8]; const float rr = 1.0f / sqrtf(wave_sum(o0 * o0 + o1 * o1) * (1.0f / 128.0f) + EPS); o0 *= rr * kg0[2 * lane]; o1 *= rr * kg0[2 * lane + 1]; }
            *(unsigned*)(dst + 2 * lane) = pk2(o0, o1);
            __builtin_amdgcn_s_waitcnt(0xc07f); asm volatile("" ::: "memory");
        }
        }

    if (PROBE_ID == 9) {
        {   pg8::TileOrder S; S.init(CQ, WUQ, 384, 384, T, 1536, G, bid);
            pg8::gemm_phase<pg8::EpiBf16, pg8::TileOrder, true>(ldsp, pg8::Gemm{384, 384, 384}, S, pg8::EpiBf16{QM, 1536, (const float*)(ws + WS_SSQCQ)}); }
        {   pg8::TileOrder S; S.init(CKV, WUKV, 256, 256, T, 2048, G, bid);
            pg8::gemm_phase<pg8::EpiKV, pg8::TileOrder, true>(ldsp, pg8::Gemm{256, 256, 256}, S, pg8::EpiKV{ws, args.in[20], (PG8_LAS float*)(ldsp + pg8::STAGE_BYTES)}); }
        {   const CmpOrder S{KCMP, VCMP, WC1K, WC1V, G, bid};
            pg8::gemm_phase<pg8::EpiSlab, CmpOrder, true>(ldsp, pg8::Gemm{2048, 4096, 4096 / NSPLIT}, S, pg8::EpiSlab{(float*)(ws + WS_CSLAB)}); } }
    if (PROBE_ID == 10) { pg8::TileOrder S; S.init(H, WOUT, DM, DM, T, DM, G, bid);
        pg8::gemm_phase<pg8::EpiResidStat<true, true>, pg8::TileOrder, true>(ldsp, pg8::Gemm{DM, DM, DM}, S, pg8::EpiResidStat<true, true>{X1B, 1.0f, H2, SS, SSO, H2F8}); }
    if (PROBE_ID == 11) { pg8::TileOrder S; S.init(ACT, WD2, DFF, DFF, T, DM, G, bid);
        pg8::gemm_phase<pg8::EpiResid, pg8::TileOrder, true>(ldsp, pg8::Gemm{DFF, DFF, DFF}, S, pg8::EpiResid{H2, out, 0.5f}); }
    if (PROBE_ID == 12) { for (int c = bid; c < 256; c += G) { const int bg = c & 7, qt = c >> 3; att::nsa_unit<2>(lds, bg >> 1, bg & 1, qt, ws);
            const int bh = bg * 4 + ((31 - qt) & 3), qb = (31 - qt) >> 2; att::mla_unit(lds, bh >> 3, bh & 7, qb, QM, KM, VM, args.in[19], ROPE, SSO, H); } }
    if (PROBE_ID == 6) { for (int c = bid; c < 256; c += G) { const int bg = c & 7; att::nsa_unit<2>(lds, bg >> 1, bg & 1, 0, ws); } }
    if (PROBE_ID == 7) { for (int c = bid; c < 256; c += G) { const int bg = c & 7; att::nsa_unit<2>(lds, bg >> 1, bg & 1, 16, ws); } }
    if (PROBE_ID == 8) { for (int c = bid; c < 256; c += G) { const int bg = c & 7; const int bh = bg * 4 + ((c >> 3) & 3); att::mla_unit(lds, bh >> 3, bh & 7, 0, QM, KM, VM, args.in[19], ROPE, SSO, H); } }
    if (PROBE_ID == 4) { for (int c = bid; c < 256; c += G) { const int bg = c & 7, qt = c >> 3; att::nsa_unit<2>(lds, bg >> 1, bg & 1, qt, ws); } }
    if (PROBE_ID == 5) { for (int c = bid; c < 256; c += G) { const int bg = c & 7, qt = c >> 3; const int bh = bg * 4 + ((31 - qt) & 3), qb = (31 - qt) >> 2; att::mla_unit(lds, bh >> 3, bh & 7, qb, QM, KM, VM, args.in[19], ROPE, SSO, H); } }
#endif
#undef WGU1
#undef WD1
#undef WGU2
#undef WD2
#undef WIN
#undef WOUT
#undef WUQ
#undef WUKV
#undef WC1K
#undef WC1V
#undef H
#undef ACT
#undef PROJ
#undef QM
#undef KNRAW
#undef KM
#undef VM
#undef QN
#undef KS
#undef VS
#undef KW
#undef VW
#undef KCMP
#undef VCMP
#undef CQ
#undef CKV
#undef KROPE
#undef GATES
#undef KC
#undef VC
#undef SS
#undef SSO
#undef H2
#undef BIASP
#undef ROPE
#undef SLAB
#undef X1B
#undef BIAS1
#undef IN
#undef SEAM
}

constexpr int NPHASES = 14;

extern "C" void kernel_launch(void* const* d_in, const int* in_sizes, int n_in, void* d_out, int out_size, void* d_ws, size_t ws_size, hipStream_t stream) {
    static int grid = 0;
    if (grid == 0) {
        if (n_in != 28 || out_size != T * DM || ws_size < WS_END) { fprintf(stderr, "kernel_launch: unexpected shapes: n_in %d out %d ws %zu (need %zu)\n", n_in, out_size, ws_size, (size_t)WS_END); grid = -1; return; }
        int dev = 0, cus = 0, per_cu = 0;
        (void)hipGetDevice(&dev); (void)hipDeviceGetAttribute(&cus, hipDeviceAttributeMultiprocessorCount, dev);
        (void)hipFuncSetAttribute((const void*)mega, hipFuncAttributeMaxDynamicSharedMemorySize, LDS_BYTES);
        (void)hipOccupancyMaxActiveBlocksPerMultiprocessor(&per_cu, (const void*)mega, NTHREADS, LDS_BYTES);
        if (per_cu < 1) { fprintf(stderr, "kernel_launch: occupancy query says %d blocks per CU\n", per_cu); per_cu = 1; }
        (void)hipGetLastError();
        grid = cus;
        if (cus != 256) { fprintf(stderr, "kernel_launch: built for a 256-CU device (one 256x256 unit per workgroup in the fused-epilogue phases); found %d CUs\n", cus); grid = -1; return; }
        fprintf(stderr, "kernel_launch: grid %d (cus %d, per_cu %d), ws %zu\n", grid, cus, per_cu, ws_size);
    }
    if (grid < 0) return;
    Args a{};
    for (int i = 0; i < 28; ++i) a.in[i] = (const float*)d_in[i];
    a.out = (float*)d_out; a.ws = (unsigned char*)d_ws;
#if MK_ONE_LAUNCH
    a.ph_lo = 0; a.ph_hi = NPHASES;
#if MK_NO_CG == 1
    (void)hipMemsetAsync((unsigned char*)d_ws + WS_BAR, 0, XCD_BAR_WORDS * 4, stream);
    hipLaunchKernelGGL(mega, dim3(grid), dim3(NTHREADS), LDS_BYTES, stream, a);
#elif MK_NO_CG == 2
    (void)hipMemsetAsync((unsigned char*)d_ws + WS_BAR, 0, XCD_BAR_WORDS * 4, stream);
    {   void* kargs[] = {&a};
        hipError_t e = hipLaunchCooperativeKernel((const void*)mega, dim3(grid), dim3(NTHREADS), kargs, LDS_BYTES, stream);
        if (e != hipSuccess) fprintf(stderr, "cooperative launch failed: %s\n", hipGetErrorString(e)); }
#else
    void* kargs[] = {&a};
    hipError_t e = hipLaunchCooperativeKernel((const void*)mega, dim3(grid), dim3(NTHREADS), kargs, LDS_BYTES, stream);
    if (e != hipSuccess) fprintf(stderr, "cooperative launch failed: %s\n", hipGetErrorString(e));
#endif
#else
    for (int p = 0; p < NPHASES; ++p) {
        a.ph_lo = p; a.ph_hi = p + 1;
        hipLaunchKernelGGL(mega, dim3(grid), dim3(NTHREADS), LDS_BYTES, stream, a);
    }
#endif
}
```
